# Optimizing an MI355X kernel written in HIP

```python
import jax, jax.numpy as jnp
from jax import lax
import numpy as np

D_MODEL = 1024
BATCH = 8
SEQ = 4096
DEPTH = 1

N_MEM = 256
RMS_EPS = 1e-6
LN_EPS = 1e-5

POOL_WINDOWS = (2, 4, 8, 16)
N_POOL_GROUPS = len(POOL_WINDOWS)
POOL_WIDTH = D_MODEL
POOL_GROUP = POOL_WIDTH // N_POOL_GROUPS

SGU_WIDTH = D_MODEL
SGU_CHUNK = 128
SGU_HEADS = 8
SGU_HEAD_DIM = SGU_WIDTH // SGU_HEADS

XA_HEADS = 4
XA_HEAD_DIM = D_MODEL // XA_HEADS
XA_WIDTH = XA_HEADS * XA_HEAD_DIM

N_BRANCHES = 3
GATE_WIDTH = N_BRANCHES * D_MODEL
IN_WIDTH = POOL_WIDTH + 2 * SGU_WIDTH + XA_WIDTH + GATE_WIDTH
SPLIT_POINTS = (POOL_WIDTH,
                POOL_WIDTH + SGU_WIDTH,
                POOL_WIDTH + 2 * SGU_WIDTH,
                POOL_WIDTH + 2 * SGU_WIDTH + XA_WIDTH)

PEER_HEADS = 8
PEER_N_KEYS = 128
PEER_N_EXPERTS = PEER_N_KEYS * PEER_N_KEYS
PEER_QUERY_DIM = 256
PEER_HALF = PEER_QUERY_DIM // 2
PEER_TOPK = 16
PEER_TOKEN_BLOCK = 128

kernel_name = "hybrid_pool_sgu_xattn_peer"


def rmsnorm(x, gain):
    xf = x.astype(jnp.float32)
    y = xf * lax.rsqrt(jnp.mean(xf * xf, axis=-1, keepdims=True) + RMS_EPS)
    return (y * gain.astype(jnp.float32)).astype(x.dtype)


def layernorm(x, gain, bias):
    xf = x.astype(jnp.float32)
    mu = jnp.mean(xf, axis=-1, keepdims=True)
    var = jnp.mean(jnp.square(xf - mu), axis=-1, keepdims=True)
    y = (xf - mu) * lax.rsqrt(var + LN_EPS)
    return (y * gain.astype(jnp.float32) + bias.astype(jnp.float32)).astype(x.dtype)


def causal_multiscale_pool(p, w_pool, pool_scale):
    B, S, _ = p.shape
    pf = p.astype(jnp.float32)
    cs = jnp.cumsum(pf, axis=1)
    t = jnp.arange(S)
    means = []
    for g, w in enumerate(POOL_WINDOWS):
        c = cs[..., g * POOL_GROUP:(g + 1) * POOL_GROUP]
        lagged = jnp.pad(c, ((0, 0), (w, 0), (0, 0)))[:, :S]
        count = jnp.minimum(t + 1, w).astype(jnp.float32)[None, :, None]
        means.append((c - lagged) / count)
    diff = (jnp.concatenate(means, axis=-1) - pf).astype(p.dtype)
    diff = diff.reshape(B, S, N_POOL_GROUPS, POOL_GROUP)
    y = jnp.einsum('bsgc,gcd->bsgd', diff, w_pool).reshape(B, S, POOL_WIDTH)
    return y * pool_scale


def chunked_spatial_gating(u, v, ln_gain, ln_bias, w_s, b_s, w_o):
    B, S, _ = u.shape
    u = jax.nn.gelu(u, approximate=False)
    v = layernorm(jax.nn.gelu(v, approximate=False), ln_gain, ln_bias)
    n_chunks = S // SGU_CHUNK
    vc = v.reshape(B, n_chunks, SGU_CHUNK, SGU_HEADS, SGU_HEAD_DIM)
    causal = jnp.tril(jnp.ones((SGU_CHUNK, SGU_CHUNK), dtype=bool))
    w_masked = jnp.where(causal[None], w_s, jnp.zeros((), w_s.dtype))
    mixed = jnp.einsum('hts,bcshd->bcthd', w_masked, vc) + b_s.T[None, None, :, :, None]
    gated = u * mixed.reshape(B, S, SGU_WIDTH)
    return gated @ w_o


def memory_cross_attention(q, mem_n, w_kv, w_o):
    B, S, _ = q.shape
    M = mem_n.shape[1]
    kv = mem_n @ w_kv
    k, v = jnp.split(kv, 2, axis=-1)
    qh = q.reshape(B, S, XA_HEADS, XA_HEAD_DIM)
    kh = k.reshape(B, M, XA_HEADS, XA_HEAD_DIM)
    vh = v.reshape(B, M, XA_HEADS, XA_HEAD_DIM)
    scores = jnp.einsum('bshd,bmhd->bhsm', qh, kh).astype(jnp.float32) * (XA_HEAD_DIM ** -0.5)
    probs = jax.nn.softmax(scores, axis=-1).astype(vh.dtype)
    o = jnp.einsum('bhsm,bmhd->bshd', probs, vh).reshape(B, S, XA_WIDTH)
    return o @ w_o


def peer_ffn(x, w_q, sub_keys1, sub_keys2, expert_u, expert_v):
    B, S, D = x.shape
    T = B * S
    xt = x.reshape(T, D)
    q = (xt @ w_q).reshape(T, PEER_HEADS, 2, PEER_HALF)
    s1 = jnp.einsum('thc,kc->thk', q[:, :, 0], sub_keys1).astype(jnp.float32)
    s2 = jnp.einsum('thc,kc->thk', q[:, :, 1], sub_keys2).astype(jnp.float32)
    v1, i1 = lax.top_k(s1, PEER_TOPK)
    v2, i2 = lax.top_k(s2, PEER_TOPK)
    cand = (v1[..., :, None] + v2[..., None, :]).reshape(T, PEER_HEADS, PEER_TOPK * PEER_TOPK)
    best, ci = lax.top_k(cand, PEER_TOPK)
    e1 = jnp.take_along_axis(i1, ci // PEER_TOPK, axis=-1)
    e2 = jnp.take_along_axis(i2, ci % PEER_TOPK, axis=-1)
    experts = e1 * PEER_N_KEYS + e2
    gates = jax.nn.softmax(best, axis=-1).astype(x.dtype)
    n_blocks = T // PEER_TOKEN_BLOCK

    def block(args):
        xb, eb, gb = args
        ub = jnp.take(expert_u, eb, axis=0)
        vb = jnp.take(expert_v, eb, axis=0)
        a = jax.nn.gelu(jnp.einsum('td,thkd->thk', xb, ub), approximate=False) * gb
        return jnp.einsum('thk,thkd->td', a, vb)

    y = lax.map(block, (xt.reshape(n_blocks, PEER_TOKEN_BLOCK, D),
                        experts.reshape(n_blocks, PEER_TOKEN_BLOCK, PEER_HEADS, PEER_TOPK),
                        gates.reshape(n_blocks, PEER_TOKEN_BLOCK, PEER_HEADS, PEER_TOPK)))
    return y.reshape(B, S, D)


def setup_inputs(seed: int = 0) -> dict:
    key = jax.random.key(seed)
    ks = jax.random.split(key, 24)
    f32 = jnp.float32
    nrm = lambda k, shape, scale: jax.random.normal(k, shape, f32) * scale
    L, D = DEPTH, D_MODEL
    return {
        "x": nrm(ks[0], (BATCH, SEQ, D), 1.0),
        "mem": nrm(ks[1], (BATCH, N_MEM, D), 1.0),
        "norm1_gain": 1.0 + nrm(ks[2], (L, D), 0.02),
        "w_in": nrm(ks[3], (L, D, IN_WIDTH), D ** -0.5),
        "pool_w": nrm(ks[4], (L, N_POOL_GROUPS, POOL_GROUP, POOL_GROUP), POOL_GROUP ** -0.5),
        "pool_scale": 1.0 + nrm(ks[5], (L, POOL_WIDTH), 0.02),
        "sgu_ln_gain": 1.0 + nrm(ks[6], (L, SGU_WIDTH), 0.02),
        "sgu_ln_bias": nrm(ks[7], (L, SGU_WIDTH), 0.02),
        "sgu_w_s": nrm(ks[8], (L, SGU_HEADS, SGU_CHUNK, SGU_CHUNK), SGU_CHUNK ** -0.5),
        "sgu_b_s": 1.0 + nrm(ks[9], (L, SGU_HEADS, SGU_CHUNK), 0.01),
        "sgu_w_out": nrm(ks[10], (L, SGU_WIDTH, D), SGU_WIDTH ** -0.5),
        "mem_norm_gain": 1.0 + nrm(ks[11], (L, D), 0.02),
        "xa_w_kv": nrm(ks[12], (L, D, 2 * XA_WIDTH), D ** -0.5),
        "xa_w_out": nrm(ks[13], (L, XA_WIDTH, D), XA_WIDTH ** -0.5),
        "w_out": nrm(ks[14], (L, D, D), D ** -0.5),
        "norm2_gain": 1.0 + nrm(ks[15], (L, D), 0.02),
        "peer_w_q": nrm(ks[16], (L, D, PEER_HEADS * PEER_QUERY_DIM), D ** -0.5),
        "peer_keys1": nrm(ks[17], (L, PEER_N_KEYS, PEER_HALF), PEER_HALF ** -0.5),
        "peer_keys2": nrm(ks[18], (L, PEER_N_KEYS, PEER_HALF), PEER_HALF ** -0.5),
        "peer_u": nrm(ks[19], (L, PEER_N_EXPERTS, D), D ** -0.5),
        "peer_v": nrm(ks[20], (L, PEER_N_EXPERTS, D), PEER_HEADS ** -0.5),
        "final_norm_gain": 1.0 + nrm(ks[21], (D,), 0.02),
    }


def reference(x, mem, norm1_gain, w_in, pool_w, pool_scale, sgu_ln_gain, sgu_ln_bias,
              sgu_w_s, sgu_b_s, sgu_w_out, mem_norm_gain, xa_w_kv, xa_w_out, w_out,
              norm2_gain, peer_w_q, peer_keys1, peer_keys2, peer_u, peer_v, final_norm_gain):
    B, S, D = x.shape
    h = x
    for l in range(DEPTH):
        n = rmsnorm(h, norm1_gain[l])
        proj = n @ w_in[l]
        p, u, v, q, g = jnp.split(proj, SPLIT_POINTS, axis=-1)
        gates = jax.nn.sigmoid(g.astype(jnp.float32)).astype(h.dtype).reshape(B, S, N_BRANCHES, D)
        y_pool = causal_multiscale_pool(p, pool_w[l], pool_scale[l])
        y_sgu = chunked_spatial_gating(u, v, sgu_ln_gain[l], sgu_ln_bias[l],
                                       sgu_w_s[l], sgu_b_s[l], sgu_w_out[l])
        y_xa = memory_cross_attention(q, rmsnorm(mem, mem_norm_gain[l]), xa_w_kv[l], xa_w_out[l])
        merged = gates[:, :, 0] * y_pool + gates[:, :, 1] * y_sgu + gates[:, :, 2] * y_xa
        h = h + merged @ w_out[l]
        h = h + peer_ffn(rmsnorm(h, norm2_gain[l]), peer_w_q[l], peer_keys1[l], peer_keys2[l],
                         peer_u[l], peer_v[l])
    return rmsnorm(h, final_norm_gain)
```

```cpp
#include <hip/hip_runtime.h>
#include <cstdio>

typedef unsigned short bf16_t;
typedef short bf16x8 __attribute__((ext_vector_type(8)));
typedef float f32x4 __attribute__((ext_vector_type(4)));

#define NTHREADS 512
#define LDS_BYTES (131072 + 256)
constexpr int T_TOK = 32768;
constexpr int SEQ = 4096;
constexpr int DM = 1024;
constexpr size_t MiB = (size_t)1 << 20;

constexpr size_t OFF_GATES = 0;
constexpr size_t OFF_Y     = 0;
constexpr size_t OFF_GU    = 192 * MiB;
constexpr size_t OFF_HB    = 192 * MiB;
constexpr size_t OFF_P     = 256 * MiB;
constexpr size_t OFF_EX    = 256 * MiB;
constexpr size_t OFF_GT    = 264 * MiB;
constexpr size_t OFF_QA    = 296 * MiB;
constexpr size_t OFF_SA    = 300 * MiB;
constexpr size_t OFF_SE    = 280 * MiB;
constexpr size_t OFF_H     = 256 * MiB;
constexpr size_t OFF_GV    = 320 * MiB;
constexpr size_t OFF_UT8   = 160 * MiB;
constexpr size_t OFF_VT8   = 176 * MiB;
constexpr size_t OFF_Q     = 384 * MiB;
constexpr size_t OFF_O     = 384 * MiB;
constexpr size_t OFF_ZP    = 384 * MiB;
constexpr size_t OFF_W     = 448 * MiB;
constexpr size_t OFF_WINT  = OFF_W;
constexpr size_t OFF_WQT   = OFF_WINT + (size_t)7168 * 1024 * 2;
constexpr size_t OFF_WKVT  = OFF_WQT + (size_t)2048 * 1024 * 2;
constexpr size_t OFF_WSOT  = OFF_WKVT + (size_t)2048 * 1024 * 2;
constexpr size_t OFF_WXOT  = OFF_WSOT + (size_t)1024 * 1024 * 2;
constexpr size_t OFF_WOUTT = OFF_WXOT + (size_t)1024 * 1024 * 2;
constexpr size_t OFF_POOLT = OFF_WOUTT + (size_t)1024 * 1024 * 2;
constexpr size_t OFF_WM    = OFF_POOLT + (size_t)4 * 256 * 256 * 2;
constexpr size_t OFF_MEMN  = OFF_WM + (size_t)8 * 128 * 128 * 2;
constexpr size_t OFF_KMAT  = OFF_MEMN + (size_t)2048 * 1024 * 2;
constexpr size_t OFF_VT    = OFF_KMAT + (size_t)2048 * 1024 * 2;
constexpr size_t OFF_RS1   = OFF_VT + (size_t)2048 * 1024 * 2;
constexpr size_t OFF_RS2   = OFF_RS1 + (size_t)T_TOK * 4;
constexpr size_t OFF_KEYB  = OFF_RS2 + (size_t)T_TOK * 4;
constexpr size_t OFF_BAR   = OFF_KEYB + (size_t)2 * 128 * 128 * 2;
constexpr size_t OFF_LSP   = OFF_BAR + 16384;
constexpr size_t OFF_SSQP  = OFF_LSP + (size_t)T_TOK * 64 * 4;
constexpr size_t OFF_WG8   = OFF_SSQP + (size_t)T_TOK * 64 * 4;
constexpr size_t OFF_US    = OFF_WG8 + (size_t)3072 * 1024;
constexpr size_t OFF_VS    = OFF_US + (size_t)16384 * 4;
constexpr size_t OFF_END   = OFF_VS + (size_t)16384 * 4;
static_assert(OFF_END <= 512 * MiB, "workspace overflow");
constexpr size_t OUT_XB = 0, OUT_DIFF = 64 * MiB, OUT_XB8 = 64 * MiB;
constexpr size_t OFF_MERGED = 256 * MiB;
#define WG8_SCALE 64.0f

struct Params {
    const float *x, *mem, *g1, *w_in, *pool_w, *pool_scale, *ln_g, *ln_b, *w_s, *b_s, *w_so, *memg, *w_kv, *w_xo, *w_out, *g2, *w_q, *k1, *k2, *pu, *pv, *gf;
    float* out; unsigned char* ws;
};

__device__ __forceinline__ int tidx() { int t = threadIdx.x; asm volatile("" : "+v"(t)); return t; }
__device__ __forceinline__ bf16_t f2bf(float f) { unsigned u = __float_as_uint(f); u += 0x7FFFu + ((u >> 16) & 1u); return (bf16_t)(u >> 16); }
__device__ __forceinline__ float bf2f(bf16_t b) { return __uint_as_float(((unsigned)b) << 16); }
__device__ __forceinline__ unsigned pack2(float a, float b) { return (unsigned)f2bf(a) | ((unsigned)f2bf(b) << 16); }
__device__ __forceinline__ float gelu_f(float v) { return 0.5f * v * (1.0f + erff(v * 0.70710678118654752f)); }
__device__ __forceinline__ float4 ldnt_f4(const float* p) { const f32x4 v = __builtin_nontemporal_load((const f32x4*)p); return make_float4(v[0], v[1], v[2], v[3]); }
__device__ __forceinline__ void stnt_f4(float* p, float4 o) { __builtin_nontemporal_store((f32x4){o.x, o.y, o.z, o.w}, (f32x4*)p); }
__device__ __forceinline__ float wave_sum(float v) {
#define WS_DPP(x, ctrl) __int_as_float(__builtin_amdgcn_update_dpp(0, __float_as_int(x), (ctrl), 0xF, 0xF, true))
    v += WS_DPP(v, 0xB1); v += WS_DPP(v, 0x4E); v += WS_DPP(v, 0x141); v += WS_DPP(v, 0x128);
#undef WS_DPP
    { const auto r = __builtin_amdgcn_permlane16_swap(__float_as_uint(v), __float_as_uint(v), false, false); v = __uint_as_float(r[0]) + __uint_as_float(r[1]); }
    { const auto r = __builtin_amdgcn_permlane32_swap(__float_as_uint(v), __float_as_uint(v), false, false); v = __uint_as_float(r[0]) + __uint_as_float(r[1]); }
    return v;
}
__device__ __forceinline__ int gwave() { return blockIdx.x * (NTHREADS / 64) + (tidx() >> 6); }
__device__ __forceinline__ int nwaves() { return gridDim.x * (NTHREADS / 64); }

template <int UNR = 2> __device__ __forceinline__ void wave_gemm_64x64(const bf16_t* __restrict__ A, int lda, const bf16_t* __restrict__ Bt, int ldb, int K, f32x4 (&acc)[4][4]) {
    const int lane = tidx() & 63, r = lane & 15, q = lane >> 4;
    const bf16_t* ap = A + (size_t)r * lda + q * 8;
    const bf16_t* bp = Bt + (size_t)r * ldb + q * 8;
    bf16x8 a[4][4], b[4][4];
#define WG_LOAD(st, kk) { _Pragma("unroll") for (int i = 0; i < 4; ++i) { a[st][i] = *(const bf16x8*)(ap + (size_t)i * 16 * lda + (kk)); b[st][i] = *(const bf16x8*)(bp + (size_t)i * 16 * ldb + (kk)); } }
#define WG_MMA(st) { _Pragma("unroll") for (int mi = 0; mi < 4; ++mi) _Pragma("unroll") for (int ni = 0; ni < 4; ++ni) acc[mi][ni] = __builtin_amdgcn_mfma_f32_16x16x32_bf16(a[st][mi], b[st][ni], acc[mi][ni], 0, 0, 0); }
    WG_LOAD(0, 0) WG_LOAD(1, 32) WG_LOAD(2, 64)
#pragma unroll 1
    for (int k = 0; k < K; k += 128) {
        const int k3 = (k + 96 < K) ? k + 96 : 0, k4 = (k + 128 < K) ? k + 128 : 0, k5 = (k + 160 < K) ? k + 160 : 0, k6 = (k + 192 < K) ? k + 192 : 0;
        WG_LOAD(3, k3) __builtin_amdgcn_sched_barrier(0); WG_MMA(0) __builtin_amdgcn_sched_barrier(0);
        WG_LOAD(0, k4) __builtin_amdgcn_sched_barrier(0); WG_MMA(1) __builtin_amdgcn_sched_barrier(0);
        WG_LOAD(1, k5) __builtin_amdgcn_sched_barrier(0); WG_MMA(2) __builtin_amdgcn_sched_barrier(0);
        WG_LOAD(2, k6) __builtin_amdgcn_sched_barrier(0); WG_MMA(3) __builtin_amdgcn_sched_barrier(0);
    }
#undef WG_LOAD
#undef WG_MMA
}
__device__ __forceinline__ void zero_acc(f32x4 (&acc)[4][4]) {
#pragma unroll
    for (int mi = 0; mi < 4; ++mi)
#pragma unroll
        for (int ni = 0; ni < 4; ++ni) acc[mi][ni] = (f32x4){0.f, 0.f, 0.f, 0.f};
}
#define STG_STRIDE 68
#define STG_FLOATS (16 * STG_STRIDE)
template <int N> struct IC { static constexpr int value = N; };
template <int MI, class F> __device__ __forceinline__ void epilogue_step(f32x4 (&acc)[4][4], float* stg, F& f) {
    const int lane = tidx() & 63, q = lane >> 4, r = lane & 15, rr = lane >> 2, cc = (lane & 3) * 16;
#pragma unroll
    for (int ni = 0; ni < 4; ++ni)
#pragma unroll
        for (int j = 0; j < 4; ++j) stg[(4 * q + j) * STG_STRIDE + 16 * ni + r] = acc[MI][ni][j];
    __builtin_amdgcn_wave_barrier(); asm volatile("s_waitcnt lgkmcnt(0)" ::: "memory");
    float v[16];
#pragma unroll
    for (int i = 0; i < 4; ++i) { const float4 t4 = *(const float4*)(stg + rr * STG_STRIDE + cc + 4 * i); v[4 * i] = t4.x; v[4 * i + 1] = t4.y; v[4 * i + 2] = t4.z; v[4 * i + 3] = t4.w; }
    asm volatile("s_waitcnt lgkmcnt(0)" ::: "memory"); __builtin_amdgcn_wave_barrier();
    f(IC<MI>{}, MI * 16 + rr, cc, v);
}
template <class F> __device__ __forceinline__ void epilogue_rows(f32x4 (&acc)[4][4], float* stg, F f) {
    epilogue_step<0>(acc, stg, f); epilogue_step<1>(acc, stg, f); epilogue_step<2>(acc, stg, f); epilogue_step<3>(acc, stg, f);
}
__device__ __forceinline__ void store16_bf16(bf16_t* dst, const float (&v)[16]) {
    uint4 a, b;
    a.x = pack2(v[0], v[1]); a.y = pack2(v[2], v[3]); a.z = pack2(v[4], v[5]); a.w = pack2(v[6], v[7]);
    b.x = pack2(v[8], v[9]); b.y = pack2(v[10], v[11]); b.z = pack2(v[12], v[13]); b.w = pack2(v[14], v[15]);
    *(uint4*)dst = a; *(uint4*)(dst + 8) = b;
}
__device__ __forceinline__ void load16_bf16(const bf16_t* src, float (&v)[16]) {
    const uint4 a = *(const uint4*)src, b = *(const uint4*)(src + 8);
    const unsigned w[8] = {a.x, a.y, a.z, a.w, b.x, b.y, b.z, b.w};
#pragma unroll
    for (int k = 0; k < 8; ++k) { v[2 * k] = __uint_as_float(w[k] << 16); v[2 * k + 1] = __uint_as_float(w[k] & 0xffff0000u); }
}


namespace pg8 {
#define PG8_LAS __attribute__((address_space(3)))
typedef unsigned u32x4 __attribute__((ext_vector_type(4)));
typedef float f32x2 __attribute__((ext_vector_type(2)));
constexpr int BM = 256, BK = 64, HALF = 128, HTB = HALF * BK * 2, STAGE_BYTES = 8 * HTB, NXCD = 8, WGM = 8;
__host__ __device__ __forceinline__ int lds_byte(int r, int c) { const int st = (r >> 4) * 2 + (c >> 5), rr = r & 15, cc = c & 31, ob = rr * 64 + cc * 2; return st * 1024 + (ob ^ (((ob >> 9) & 1) << 5)); }
__host__ __device__ __forceinline__ void stage_rc(int b, int& R, int& C) { const int st = b / 1024, sb = b % 1024, swz = sb ^ (((sb >> 9) & 1) << 5); R = (st >> 1) * 16 + swz / 64; C = (st & 1) * 32 + (swz % 64) / 2; }
__host__ __device__ __forceinline__ int perm32(int rho) { const int n = rho >> 4, i = rho & 15; return 8 * (i >> 2) + 4 * n + (i & 3); }
struct Unit { int pm, pn; };
struct Gemm { const bf16_t* A; const bf16_t* Bt; int lda, ldb, K; size_t a_pm, a_pn, b_pn; size_t b_pm = 0; int b_sh = 0; };
struct StaticOrder {
    int nM, nN, nwg, G, c;
    __device__ void init(int M, int N, int G_, int c_) { nM = M / BM; nN = N / BM; nwg = nM * nN; G = G_; c = c_; }
    __device__ bool next(int i, Unit& u) const {
        const long L = (long)i * G + c; if (L >= nwg) return false;
        int wgid = (int)L; { const int q = nwg / NXCD, r = nwg % NXCD, xcd = wgid % NXCD, off = wgid / NXCD; wgid = (xcd < r ? xcd * (q + 1) : r * (q + 1) + (xcd - r) * q) + off; }
        const int nig = WGM * nN, gid = wgid / nig, fm = gid * WGM, gsz = (nM - fm) < WGM ? (nM - fm) : WGM;
        u.pm = fm + ((wgid % nig) % gsz); u.pn = (wgid % nig) / gsz; return true;
    }
};
typedef __bf16 bf16x2_t __attribute__((ext_vector_type(2)));
__device__ __forceinline__ unsigned cvt_pk_bf16(float lo, float hi) { return __builtin_bit_cast(unsigned, __builtin_convertvector((f32x2){lo, hi}, bf16x2_t)); }
__device__ __forceinline__ f32x2 gelu_pk(f32x2 v) {
    const f32x2 av = __builtin_elementwise_abs(v), d = av * 0.2316418882f + 1.0f;
    f32x2 t; t.x = __builtin_amdgcn_rcpf(d.x); t.y = __builtin_amdgcn_rcpf(d.y);
    f32x2 q = t * 0.5307027145f + (-0.7265760135f); q = q * t + 0.7107068705f; q = q * t + (-0.142248368f); q = q * t + 0.127414796f; q = q * t;
    const f32x2 s = (v * v) * (-0.72134752044f);
    f32x2 e; e.x = __builtin_amdgcn_exp2f(s.x); e.y = __builtin_amdgcn_exp2f(s.y);
    f32x2 mx; mx.x = fmaxf(v.x, 0.f); mx.y = fmaxf(v.y, 0.f);
    return mx - av * (q * e);
}
typedef int i32x8 __attribute__((ext_vector_type(8)));
template <class Epi, class Sched, bool FP8 = false>
__device__ __forceinline__ void gemm_phase(PG8_LAS unsigned char* lds, const Gemm g, const Sched& S, const Epi& E) {
    const int tid = tidx(), wid = __builtin_amdgcn_readfirstlane(tid >> 6), lane = tid & 63, wr = wid >> 2, wc = wid & 3, fr = lane & 15, fq = lane >> 4;
    const int K = g.K, nt = K / BK;
    unsigned voffA[2], voffB[2];
#pragma unroll
    for (int i = 0; i < 2; ++i) { int R, C; stage_rc(tid * 16 + i * 8192, R, C); const int Rb = Epi::PERM ? ((R & ~31) + perm32(R & 31)) : R;
        voffA[i] = (unsigned)(R * g.lda + C) * 2u; voffB[i] = (unsigned)(Rb * g.ldb + C) * 2u; }
    const size_t kstep = (size_t)(BK * 2);
    const size_t hstepA = (size_t)HALF * g.lda * 2, hstepB = (size_t)HALF * g.ldb * 2;
    const unsigned ldsw = (unsigned)wid * 1024u;
    const int aoff = lds_byte(wr * 64 + fr, fq * 8), boff = lds_byte(wc * 32 + fr, fq * 8);
#define PG8_SA(b, h) (((b) * 2 + (h)) * HTB)
#define PG8_SB(b, h) ((4 + (b) * 2 + (h)) * HTB)
#define PG8_STAGE(bufoff, gbase, voff) do { _Pragma("unroll") for (int _i = 0; _i < 2; ++_i) \
        __builtin_amdgcn_global_load_lds((const unsigned*)((const char*)(gbase) + (voff)[_i]), (PG8_LAS unsigned*)(lds + (bufoff) + ldsw + _i * 8192), 16, 0, 0); } while (0)
#define PG8_LDA(dst, b, h) do { _Pragma("unroll") for (int m = 0; m < 4; ++m) _Pragma("unroll") for (int k = 0; k < 2; ++k) dst[m][k] = *(const PG8_LAS bf16x8*)(lds + PG8_SA(b, h) + aoff + m * 2048 + k * 1024); } while (0)
#define PG8_LDB(dst, b, h) do { _Pragma("unroll") for (int n = 0; n < 2; ++n) _Pragma("unroll") for (int k = 0; k < 2; ++k) dst[n][k] = *(const PG8_LAS bf16x8*)(lds + PG8_SB(b, h) + boff + n * 2048 + k * 1024); } while (0)
#define PG8_CAT8(X0, X1) ({ const u32x4 x0_ = __builtin_bit_cast(u32x4, X0), x1_ = __builtin_bit_cast(u32x4, X1); (i32x8){(int)x0_[0], (int)x0_[1], (int)x0_[2], (int)x0_[3], (int)x1_[0], (int)x1_[1], (int)x1_[2], (int)x1_[3]}; })
#define PG8_MMA(ai, bj, At, Bt) do { __builtin_amdgcn_s_setprio(1); _Pragma("unroll") for (int m = 0; m < 4; ++m) _Pragma("unroll") for (int n = 0; n < 2; ++n) { \
        if constexpr (FP8) { const i32x8 a8_ = PG8_CAT8(Bt[n][0], Bt[n][1]), b8_ = PG8_CAT8(At[m][0], At[m][1]); \
            asm volatile("v_mfma_scale_f32_16x16x128_f8f6f4 %0, %1, %2, %0, %3, %3 op_sel_hi:[0,0,0]" : "+v"(acc[ai][bj][m][n]) : "v"(a8_), "v"(b8_), "v"(sc1)); } \
        else { _Pragma("unroll") for (int k = 0; k < 2; ++k) acc[ai][bj][m][n] = __builtin_amdgcn_mfma_f32_16x16x32_bf16(Bt[n][k], At[m][k], acc[ai][bj][m][n], 0, 0, 0); } } \
        __builtin_amdgcn_s_setprio(0); } while (0)
#define PG8_WAIT_V(n) asm volatile("s_waitcnt vmcnt(" #n ")" ::: "memory")
#define PG8_WAIT_L(n) asm volatile("s_waitcnt lgkmcnt(" #n ")" ::: "memory")
#define PG8_BAR __builtin_amdgcn_s_barrier()
#define PG8_SCHED __builtin_amdgcn_sched_barrier(0)
    const int sc1 = 0x7f7f7f7f; (void)sc1;
    Unit cur, nxt; int ui = 0;
    if (!S.next(0, cur)) return;
    f32x4 acc[2][2][4][2];
#pragma unroll
    for (int a = 0; a < 2; ++a)
#pragma unroll
        for (int b = 0; b < 2; ++b)
#pragma unroll
            for (int m = 0; m < 4; ++m)
#pragma unroll
                for (int n = 0; n < 2; ++n) acc[a][b][m][n] = (f32x4){0.f, 0.f, 0.f, 0.f};
    bf16x8 At[4][2], B0[2][2], B1[2][2];
    const char* cA = (const char*)g.A + (size_t)cur.pm * g.a_pm + (size_t)cur.pn * g.a_pn; const char* cB = (const char*)g.Bt + (size_t)cur.pn * g.b_pn + (size_t)(cur.pm >> g.b_sh) * g.b_pm;
    PG8_STAGE(PG8_SB(0, 0), cB, voffB); PG8_STAGE(PG8_SB(0, 1), cB + hstepB, voffB); PG8_STAGE(PG8_SA(0, 0), cA, voffA); PG8_STAGE(PG8_SA(0, 1), cA + hstepA, voffA);
    if (wr == 1) PG8_BAR;
    PG8_WAIT_V(2); PG8_BAR;
    PG8_STAGE(PG8_SB(1, 0), cB + kstep, voffB); PG8_STAGE(PG8_SA(1, 0), cA + kstep, voffA); PG8_STAGE(PG8_SB(1, 1), cB + hstepB + kstep, voffB);
    PG8_WAIT_V(6); PG8_BAR;
    for (;;) {
        const bool has_next = S.next(ui + 1, nxt);
        const char* nA = has_next ? (const char*)g.A + (size_t)nxt.pm * g.a_pm + (size_t)nxt.pn * g.a_pn : cA; const char* nB = has_next ? (const char*)g.Bt + (size_t)nxt.pn * g.b_pn + (size_t)(nxt.pm >> g.b_sh) * g.b_pm : cB;
#pragma unroll 1
        for (int t = 0; t < nt; t += 2) {
            const bool last = (t == nt - 2);
            const char* a1 = cA + (size_t)(t + 1) * kstep;
            const char* a2 = last ? nA : cA + (size_t)(t + 2) * kstep; const char* b2 = last ? nB : cB + (size_t)(t + 2) * kstep;
            const char* a3 = a2 + kstep; const char* b3 = b2 + kstep;
            PG8_LDB(B0, 0, 0); PG8_LDB(B1, 0, 1); PG8_SCHED; PG8_LDA(At, 0, 0); PG8_STAGE(PG8_SA(1, 1), a1 + hstepA, voffA);
            PG8_WAIT_V(8); PG8_WAIT_L(0); PG8_BAR; PG8_MMA(0, 0, At, B0); PG8_MMA(0, 1, At, B1); PG8_BAR; PG8_SCHED;
            PG8_LDA(At, 0, 1); PG8_STAGE(PG8_SB(0, 0), b2, voffB); PG8_STAGE(PG8_SB(0, 1), b2 + hstepB, voffB); PG8_STAGE(PG8_SA(0, 0), a2, voffA);
            PG8_WAIT_V(8); PG8_WAIT_L(0); PG8_BAR; PG8_MMA(1, 0, At, B0); PG8_MMA(1, 1, At, B1); PG8_BAR; PG8_SCHED;
            PG8_LDB(B0, 1, 0); PG8_LDB(B1, 1, 1); PG8_SCHED; PG8_LDA(At, 1, 0); PG8_STAGE(PG8_SA(0, 1), a2 + hstepA, voffA);
            PG8_WAIT_V(8); PG8_WAIT_L(0); PG8_BAR; PG8_MMA(0, 0, At, B0); PG8_MMA(0, 1, At, B1); PG8_BAR; PG8_SCHED;
            PG8_LDA(At, 1, 1); PG8_STAGE(PG8_SB(1, 0), b3, voffB); PG8_STAGE(PG8_SB(1, 1), b3 + hstepB, voffB); PG8_STAGE(PG8_SA(1, 0), a3, voffA);
            PG8_WAIT_V(8); PG8_WAIT_L(0); PG8_BAR; PG8_MMA(1, 0, At, B0); PG8_MMA(1, 1, At, B1); PG8_BAR; PG8_SCHED;
        }
        if (wr == 0) PG8_BAR;
        if constexpr (FP8) asm volatile("s_nop 15\n\ts_nop 15" ::: "memory");
        E(acc, cur, wr, wc, fr, fq);
        if (!has_next) break;
#pragma unroll
        for (int a = 0; a < 2; ++a)
#pragma unroll
            for (int b = 0; b < 2; ++b)
#pragma unroll
                for (int m = 0; m < 4; ++m)
#pragma unroll
                    for (int n = 0; n < 2; ++n) acc[a][b][m][n] = (f32x4){0.f, 0.f, 0.f, 0.f};
        cur = nxt; cA = nA; cB = nB; ++ui;
        if (wr == 1) PG8_BAR;
    }
    PG8_WAIT_V(0);
    PG8_BAR;
#undef PG8_SA
#undef PG8_SB
#undef PG8_STAGE
#undef PG8_LDA
#undef PG8_LDB
#undef PG8_MMA
#undef PG8_CAT8
#undef PG8_WAIT_V
#undef PG8_WAIT_L
#undef PG8_BAR
#undef PG8_SCHED
}
struct EpiPlain {
    static constexpr bool PERM = true;
    bf16_t* out; int ld;
    __device__ __forceinline__ void operator()(const f32x4 (&acc)[2][2][4][2], const Unit& u, int wr, int wc, int fr, int fq) const {
        const int row0 = u.pm * BM + wr * 64 + fr, col0 = u.pn * BM + wc * 32 + 8 * fq;
#pragma unroll
        for (int ai = 0; ai < 2; ++ai)
#pragma unroll
            for (int m = 0; m < 4; ++m) {
                bf16_t* rowp = out + (size_t)(row0 + ai * HALF + m * 16) * ld + col0;
#pragma unroll
                for (int bj = 0; bj < 2; ++bj) {
                    const f32x4 v0 = acc[ai][bj][m][0], v1 = acc[ai][bj][m][1];
                    u32x4 w; w.x = cvt_pk_bf16(v0[0], v0[1]); w.y = cvt_pk_bf16(v0[2], v0[3]); w.z = cvt_pk_bf16(v1[0], v1[1]); w.w = cvt_pk_bf16(v1[2], v1[3]);
                    *(u32x4*)(rowp + bj * HALF) = w;
                }
            }
    }
};
__device__ __forceinline__ unsigned pack_unorm8x4(float a, float b, float c, float d) {
    const unsigned ya = __float_as_uint(fmaf(a, 255.0f, 12582912.0f)), yb = __float_as_uint(fmaf(b, 255.0f, 12582912.0f));
    const unsigned yc = __float_as_uint(fmaf(c, 255.0f, 12582912.0f)), yd = __float_as_uint(fmaf(d, 255.0f, 12582912.0f));
    const unsigned t01 = __builtin_amdgcn_perm(yb, ya, 0x00000400u), t23 = __builtin_amdgcn_perm(yd, yc, 0x00000400u);
    return __builtin_amdgcn_perm(t23, t01, 0x05040100u);
}
template <int MODE> struct EpiSeg {
    static constexpr bool PERM = true;
    const float* rs1; bf16_t* out; int ld; float oscale = 1.0f; bf16_t* out2 = nullptr; int nsplit = 1 << 20;
    __device__ __forceinline__ void operator()(const f32x4 (&acc)[2][2][4][2], const Unit& u, int wr, int wc, int fr, int fq) const {
        const bool second = u.pn >= nsplit;
        bf16_t* const ob = second ? out2 : out;
        const int row0 = u.pm * BM + wr * 64 + fr, col0 = (second ? u.pn - nsplit : u.pn) * BM + wc * 32 + 8 * fq;
#pragma unroll
        for (int ai = 0; ai < 2; ++ai)
#pragma unroll
            for (int m = 0; m < 4; ++m) {
                const int row = row0 + ai * HALF + m * 16; const float rs = rs1[row] * oscale;
                bf16_t* rowp = ob + (size_t)row * ld + col0;
#pragma unroll
                for (int bj = 0; bj < 2; ++bj) {
                    f32x4 v0 = acc[ai][bj][m][0] * rs, v1 = acc[ai][bj][m][1] * rs;
                    if (MODE == 1) {
                        const f32x2 a = gelu_pk((f32x2){v0[0], v0[1]}), b = gelu_pk((f32x2){v0[2], v0[3]}), c = gelu_pk((f32x2){v1[0], v1[1]}), d = gelu_pk((f32x2){v1[2], v1[3]});
                        v0 = (f32x4){a.x, a.y, b.x, b.y}; v1 = (f32x4){c.x, c.y, d.x, d.y};
                    } else if (MODE == 2) { v0 = v0 * 0.0625f; v1 = v1 * 0.0625f; }
                    else if (MODE == 3) {
#pragma unroll
                        for (int j = 0; j < 4; ++j) { v0[j] = __builtin_amdgcn_rcpf(1.0f + __expf(-v0[j])); v1[j] = __builtin_amdgcn_rcpf(1.0f + __expf(-v1[j])); }
                    }
                    if (MODE == 3) {
                        uint2 w8; w8.x = pack_unorm8x4(v0[0], v0[1], v0[2], v0[3]); w8.y = pack_unorm8x4(v1[0], v1[1], v1[2], v1[3]);
                        *(uint2*)((unsigned char*)ob + (size_t)row * ld + col0 + bj * HALF) = w8;
                    } else {
                    u32x4 w; w.x = cvt_pk_bf16(v0[0], v0[1]); w.y = cvt_pk_bf16(v0[2], v0[3]); w.z = cvt_pk_bf16(v1[0], v1[1]); w.w = cvt_pk_bf16(v1[2], v1[3]);
                    *(u32x4*)(rowp + bj * HALF) = w;
                    }
                }
            }
    }
};
template <int PASS> struct EpiMerged {
    static constexpr bool PERM = true;
    const unsigned char* GATES; bf16_t* MERGED; const float* pool_scale;
    __device__ __forceinline__ void operator()(const f32x4 (&acc)[2][2][4][2], const Unit& u, int wr, int wc, int fr, int fq) const {
        const int row0 = u.pm * BM + wr * 64 + fr, col0 = u.pn * BM + wc * 32 + 8 * fq;
        constexpr int goff = PASS == 0 ? 1024 : (PASS == 1 ? 2048 : 0);
        const unsigned char* gp = GATES + (size_t)row0 * 3072 + goff + col0;
        bf16_t* mp0 = MERGED + (size_t)row0 * 1024 + col0;
        uint2 gw[4][2]; u32x4 old[4][2];
#define EM_LOAD(r)                                                                                              \
    {                                                                                                           \
        const int rr_ = ((r) >> 2) * HALF + ((r) & 3) * 16;                                                     \
        _Pragma("unroll") for (int bj = 0; bj < 2; ++bj) {                                                      \
            gw[(r) & 3][bj] = *(const uint2*)(gp + (size_t)rr_ * 3072 + bj * HALF);                              \
            if (PASS != 0) old[(r) & 3][bj] = *(const u32x4*)(mp0 + (size_t)rr_ * 1024 + bj * HALF);            \
        }                                                                                                       \
    }
        EM_LOAD(0) EM_LOAD(1) EM_LOAD(2) EM_LOAD(3)
        f32x4 ps[2][2];
        if (PASS == 2) {
#pragma unroll
            for (int bj = 0; bj < 2; ++bj) { ps[bj][0] = *(const f32x4*)(pool_scale + col0 + bj * HALF); ps[bj][1] = *(const f32x4*)(pool_scale + col0 + bj * HALF + 4); }
        }
        asm volatile("" ::: "memory");
#pragma unroll
        for (int r = 0; r < 8; ++r) {
            const int ai = r >> 2, m = r & 3;
            u32x4 w[2];
#pragma unroll
            for (int bj = 0; bj < 2; ++bj) {
                float val[8];
#pragma unroll
                for (int j = 0; j < 4; ++j) {
                    const unsigned ga = gw[r & 3][bj].x, gb = gw[r & 3][bj].y;
                    val[j] = acc[ai][bj][m][0][j] * ((float)((ga >> (8 * j)) & 0xffu) * (1.0f / 255.0f));
                    val[4 + j] = acc[ai][bj][m][1][j] * ((float)((gb >> (8 * j)) & 0xffu) * (1.0f / 255.0f));
                }
                if (PASS == 2) {
#pragma unroll
                    for (int j = 0; j < 4; ++j) { val[j] *= ps[bj][0][j]; val[4 + j] *= ps[bj][1][j]; }
                }
                if (PASS != 0) {
#pragma unroll
                    for (int j = 0; j < 4; ++j) { const unsigned o2 = old[r & 3][bj][j]; val[2 * j] += __uint_as_float(o2 << 16); val[2 * j + 1] += __uint_as_float(o2 & 0xffff0000u); }
                }
                w[bj].x = cvt_pk_bf16(val[0], val[1]); w[bj].y = cvt_pk_bf16(val[2], val[3]); w[bj].z = cvt_pk_bf16(val[4], val[5]); w[bj].w = cvt_pk_bf16(val[6], val[7]);
            }
            if (r + 4 < 8) EM_LOAD(r + 4)
            {
                const int rr = ai * HALF + m * 16;
#pragma unroll
                for (int bj = 0; bj < 2; ++bj) *(u32x4*)(mp0 + (size_t)rr * 1024 + bj * HALF) = w[bj];
            }
            asm volatile("" ::: "memory");
        }
#undef EM_LOAD
    }
};
struct EpiS {
    static constexpr bool PERM = true;
    bf16_t* PM; float* LSP;
    __device__ __forceinline__ void operator()(const f32x4 (&acc)[2][2][4][2], const Unit& u, int wr, int wc, int fr, int fq) const {
        const int row0 = u.pm * BM + wr * 64 + fr, col0 = u.pn * BM + wc * 32 + 8 * fq;
#pragma unroll
        for (int ai = 0; ai < 2; ++ai)
#pragma unroll
            for (int m = 0; m < 4; ++m) {
                const int row = row0 + ai * HALF + m * 16;
                bf16_t* rowp = PM + (size_t)row * 1024 + col0;
                float rsum = 0.f;
#pragma unroll
                for (int bj = 0; bj < 2; ++bj) {
                    f32x4 v0 = acc[ai][bj][m][0], v1 = acc[ai][bj][m][1];
#pragma unroll
                    for (int j = 0; j < 4; ++j) { v0[j] = __expf(fminf(v0[j], 60.f)); v1[j] = __expf(fminf(v1[j], 60.f)); }
                    u32x4 w; w.x = cvt_pk_bf16(v0[0], v0[1]); w.y = cvt_pk_bf16(v0[2], v0[3]); w.z = cvt_pk_bf16(v1[0], v1[1]); w.w = cvt_pk_bf16(v1[2], v1[3]);
                    *(u32x4*)(rowp + bj * HALF) = w;
#pragma unroll
                    for (int j = 0; j < 4; ++j) rsum += __uint_as_float(w[j] << 16) + __uint_as_float(w[j] & 0xffff0000u);
                }
                LSP[((size_t)row * 4 + u.pn) * 16 + wc * 4 + fq] = rsum;
            }
    }
};
struct EpiPV {
    static constexpr bool PERM = true;
    bf16_t* O; const float* LSP;
    __device__ __forceinline__ void operator()(const f32x4 (&acc)[2][2][4][2], const Unit& u, int wr, int wc, int fr, int fq) const {
        const int row0 = u.pm * BM + wr * 64 + fr, col0 = u.pn * BM + wc * 32 + 8 * fq;
        const float* lp0 = LSP + ((size_t)row0 * 4 + u.pn) * 16;
        bf16_t* op0 = O + (size_t)row0 * 1024 + col0;
        f32x4 lq[4][4];
#define PV_LOAD(r)                                                                                              \
    {                                                                                                           \
        const float* lpp_ = lp0 + (size_t)(((r) >> 2) * HALF + ((r) & 3) * 16) * 64;                            \
        _Pragma("unroll") for (int q = 0; q < 4; ++q) lq[(r) & 3][q] = *(const f32x4*)(lpp_ + 4 * q);           \
    }
        PV_LOAD(0) PV_LOAD(1) PV_LOAD(2) PV_LOAD(3)
        asm volatile("" ::: "memory");
#pragma unroll
        for (int r = 0; r < 8; ++r) {
            const int ai = r >> 2, m = r & 3;
            const f32x4 ls = (lq[r & 3][0] + lq[r & 3][1]) + (lq[r & 3][2] + lq[r & 3][3]);
            const float inv = __builtin_amdgcn_rcpf((ls[0] + ls[1]) + (ls[2] + ls[3]));
            u32x4 w[2];
#pragma unroll
            for (int bj = 0; bj < 2; ++bj) {
                const f32x4 v0 = acc[ai][bj][m][0] * inv, v1 = acc[ai][bj][m][1] * inv;
                w[bj].x = cvt_pk_bf16(v0[0], v0[1]); w[bj].y = cvt_pk_bf16(v0[2], v0[3]); w[bj].z = cvt_pk_bf16(v1[0], v1[1]); w[bj].w = cvt_pk_bf16(v1[2], v1[3]);
            }
            if (r + 4 < 8) PV_LOAD(r + 4)
#pragma unroll
            for (int bj = 0; bj < 2; ++bj) *(u32x4*)(op0 + (size_t)(ai * HALF + m * 16) * 1024 + bj * HALF) = w[bj];
            asm volatile("" ::: "memory");
        }
#undef PV_LOAD
    }
};
struct EpiH {
    static constexpr bool PERM = true;
    const bf16_t* xb; bf16_t* HB; float* SSQP;
    __device__ __forceinline__ void operator()(const f32x4 (&acc)[2][2][4][2], const Unit& u, int wr, int wc, int fr, int fq) const {
        const int row0 = u.pm * BM + wr * 64 + fr, col0 = u.pn * BM + wc * 32 + 8 * fq;
        const bf16_t* xp0 = xb + (size_t)row0 * 1024 + col0;
        bf16_t* hp0 = HB + (size_t)row0 * 1024 + col0;
        float* sp0 = SSQP + (size_t)row0 * 64 + u.pn * 16 + wc * 4 + fq;
        u32x4 xv[8][2];
#pragma unroll
        for (int r = 0; r < 8; ++r)
#pragma unroll
            for (int bj = 0; bj < 2; ++bj) xv[r][bj] = *(const u32x4*)(xp0 + (size_t)((r >> 2) * HALF + (r & 3) * 16) * 1024 + bj * HALF);
        asm volatile("" ::: "memory");
#pragma unroll
        for (int r = 0; r < 8; ++r) {
            const int ai = r >> 2, m = r & 3;
            const size_t ro = (size_t)(ai * HALF + m * 16);
            float ss = 0.f;
            u32x4 w[2];
#pragma unroll
            for (int bj = 0; bj < 2; ++bj) {
                const u32x4 xw = xv[r][bj];
                const f32x4 h0 = (f32x4){__uint_as_float(xw[0] << 16), __uint_as_float(xw[0] & 0xffff0000u), __uint_as_float(xw[1] << 16), __uint_as_float(xw[1] & 0xffff0000u)} + acc[ai][bj][m][0];
                const f32x4 h1 = (f32x4){__uint_as_float(xw[2] << 16), __uint_as_float(xw[2] & 0xffff0000u), __uint_as_float(xw[3] << 16), __uint_as_float(xw[3] & 0xffff0000u)} + acc[ai][bj][m][1];
                w[bj].x = cvt_pk_bf16(h0[0], h0[1]); w[bj].y = cvt_pk_bf16(h0[2], h0[3]); w[bj].z = cvt_pk_bf16(h1[0], h1[1]); w[bj].w = cvt_pk_bf16(h1[2], h1[3]);
                ss += (h0[0] * h0[0] + h0[1] * h0[1]) + (h0[2] * h0[2] + h0[3] * h0[3]) + (h1[0] * h1[0] + h1[1] * h1[1]) + (h1[2] * h1[2] + h1[3] * h1[3]);
            }
#pragma unroll
            for (int bj = 0; bj < 2; ++bj) *(u32x4*)(hp0 + ro * 1024 + bj * HALF) = w[bj];
            sp0[ro * 64] = ss;
            asm volatile("" ::: "memory");
        }
    }
};
struct EpiQ2 {
    static constexpr bool PERM = true;
    const float* rs2; bf16_t* Q2;
    __device__ __forceinline__ void operator()(const f32x4 (&acc)[2][2][4][2], const Unit& u, int wr, int wc, int fr, int fq) const {
        const int row0 = u.pm * BM + wr * 64 + fr, col0 = u.pn * BM + wc * 32 + 8 * fq;
#pragma unroll
        for (int ai = 0; ai < 2; ++ai)
#pragma unroll
            for (int m = 0; m < 4; ++m) {
                const int row = row0 + ai * HALF + m * 16; const float rs = rs2[row];
                bf16_t* rowp = Q2 + (size_t)row * 2048 + col0;
#pragma unroll
                for (int bj = 0; bj < 2; ++bj) {
                    const f32x4 v0 = acc[ai][bj][m][0] * rs, v1 = acc[ai][bj][m][1] * rs;
                    u32x4 w; w.x = cvt_pk_bf16(v0[0], v0[1]); w.y = cvt_pk_bf16(v0[2], v0[3]); w.z = cvt_pk_bf16(v1[0], v1[1]); w.w = cvt_pk_bf16(v1[2], v1[3]);
                    *(u32x4*)(rowp + bj * HALF) = w;
                }
            }
    }
};
}

__device__ __forceinline__ void rows_prep(const float* __restrict__ src, int nrows, bf16_t* __restrict__ dst, float* __restrict__ rs_out, const float* __restrict__ gain, bool apply, unsigned* __restrict__ dst8 = nullptr) {
    const int lane = tidx() & 63;
    int t0 = gwave() * 4;
    if (t0 >= nrows) return;
    float4 vn[4][4];
#pragma unroll
    for (int r = 0; r < 4; ++r)
#pragma unroll
        for (int i = 0; i < 4; ++i) vn[r][i] = ldnt_f4(src + (size_t)(t0 + r) * DM + (lane + 64 * i) * 4);
    for (; t0 < nrows; t0 += nwaves() * 4) {
        float4 v[4][4];
#pragma unroll
        for (int r = 0; r < 4; ++r)
#pragma unroll
            for (int i = 0; i < 4; ++i) v[r][i] = vn[r][i];
        const int t1 = t0 + nwaves() * 4;
        if (t1 < nrows) {
#pragma unroll
            for (int r = 0; r < 4; ++r)
#pragma unroll
                for (int i = 0; i < 4; ++i) vn[r][i] = ldnt_f4(src + (size_t)(t1 + r) * DM + (lane + 64 * i) * 4);
        }
#pragma unroll
        for (int r = 0; r < 4; ++r) {
            float ss = 0.f;
#pragma unroll
            for (int i = 0; i < 4; ++i) ss += v[r][i].x * v[r][i].x + v[r][i].y * v[r][i].y + v[r][i].z * v[r][i].z + v[r][i].w * v[r][i].w;
            ss = wave_sum(ss);
            const float rs = rsqrtf(ss * (1.0f / DM) + 1e-6f);
            if (rs_out && lane == 0) rs_out[t0 + r] = rs;
#pragma unroll
            for (int i = 0; i < 4; ++i) {
                float4 o = v[r][i];
                if (apply) { const float4 g = ((const float4*)gain)[lane + 64 * i]; o.x *= rs * g.x; o.y *= rs * g.y; o.z *= rs * g.z; o.w *= rs * g.w; }
                uint2 w; w.x = pack2(o.x, o.y); w.y = pack2(o.z, o.w);
                *(uint2*)(dst + (size_t)(t0 + r) * DM + (lane + 64 * i) * 4) = w;
                if (dst8) { int w8 = 0; w8 = __builtin_amdgcn_cvt_pk_fp8_f32(o.x, o.y, w8, false); w8 = __builtin_amdgcn_cvt_pk_fp8_f32(o.z, o.w, w8, true); dst8[(size_t)(t0 + r) * (DM / 4) + lane + 64 * i] = (unsigned)w8; }
            }
        }
    }
}
struct TItem { const float* W; const float* scale; unsigned char* WT; int ldw, K, k0, n0, fp8; };
__device__ __forceinline__ void titem_load(const TItem& d, int lane, float (&v)[32], float4& s0, float4& s1) {
#pragma unroll
    for (int i = 0; i < 32; ++i) v[i] = __builtin_nontemporal_load(d.W + (size_t)(d.k0 + 2 * i + (lane >> 5)) * d.ldw + d.n0 + (lane & 31));
    s0 = make_float4(1.f, 1.f, 1.f, 1.f); s1 = s0;
    if (d.scale) { s0 = *(const float4*)(d.scale + d.k0 + 8 * (lane & 7)); s1 = *(const float4*)(d.scale + d.k0 + 8 * (lane & 7) + 4); }
}
__device__ __forceinline__ void titem_finish(const TItem& d, float* scr, int lane, const float (&v)[32], float4 s0, float4 s1) {
    const int c = lane & 7;
#pragma unroll
    for (int i = 0; i < 32; ++i) scr[(2 * i + (lane >> 5)) * 33 + (lane & 31)] = v[i];
    __builtin_amdgcn_wave_barrier(); asm volatile("s_waitcnt lgkmcnt(0)" ::: "memory");
    if (d.fp8) {
#pragma unroll
        for (int j = 0; j < 4; ++j) { const int n = (lane >> 3) + 8 * j; const float* sp = scr + (8 * c) * 33 + n;
            int w0 = 0, w1 = 0;
            w0 = __builtin_amdgcn_cvt_pk_fp8_f32(sp[0 * 33] * (s0.x * WG8_SCALE), sp[1 * 33] * (s0.y * WG8_SCALE), w0, false); w0 = __builtin_amdgcn_cvt_pk_fp8_f32(sp[2 * 33] * (s0.z * WG8_SCALE), sp[3 * 33] * (s0.w * WG8_SCALE), w0, true);
            w1 = __builtin_amdgcn_cvt_pk_fp8_f32(sp[4 * 33] * (s1.x * WG8_SCALE), sp[5 * 33] * (s1.y * WG8_SCALE), w1, false); w1 = __builtin_amdgcn_cvt_pk_fp8_f32(sp[6 * 33] * (s1.z * WG8_SCALE), sp[7 * 33] * (s1.w * WG8_SCALE), w1, true);
            uint2 o; o.x = (unsigned)w0; o.y = (unsigned)w1;
            *(uint2*)(d.WT + (size_t)(d.n0 + n) * d.K + d.k0 + 8 * c) = o; }
    } else {
#pragma unroll
        for (int j = 0; j < 4; ++j) { const int n = (lane >> 3) + 8 * j; const float* sp = scr + (8 * c) * 33 + n;
            uint4 o; o.x = pack2(sp[0 * 33] * s0.x, sp[1 * 33] * s0.y); o.y = pack2(sp[2 * 33] * s0.z, sp[3 * 33] * s0.w); o.z = pack2(sp[4 * 33] * s1.x, sp[5 * 33] * s1.y); o.w = pack2(sp[6 * 33] * s1.z, sp[7 * 33] * s1.w);
            *(uint4*)(d.WT + ((size_t)(d.n0 + n) * d.K + d.k0 + 8 * c) * 2) = o; }
    }
    asm volatile("s_waitcnt lgkmcnt(0)" ::: "memory"); __builtin_amdgcn_wave_barrier();
}
__device__ __forceinline__ void p0_prep(const Params& p, float* lds) {
    unsigned char* ws = p.ws;
    rows_prep(p.x, T_TOK, (bf16_t*)((unsigned char*)p.out + OUT_XB), (float*)(ws + OFF_RS1), nullptr, false, (unsigned*)((unsigned char*)p.out + OUT_XB8));
    rows_prep(p.mem, 2048, (bf16_t*)(ws + OFF_MEMN), nullptr, p.memg, true);
    {
        const int lane = tidx() & 63; float* scr = lds + (tidx() >> 6) * (64 * 33);
        constexpr int I_IN = 16 * 128, I_Q = 16 * 64, I_KV = 16 * 64, I_SQ = 16 * 32, I_PL = 4 * 8;
        constexpr int I_G8 = 16 * 96;
        constexpr int NIT = I_G8 + I_IN + I_Q + I_KV + 3 * I_SQ + 4 * I_PL;
        auto mk = [&](const float* W, int ldw, int ncols, const float* scale, unsigned char* WT, int K, int fp8, int item) {
            TItem d; const int nblk = ncols / 32; d.W = W; d.scale = scale; d.WT = WT; d.ldw = ldw; d.K = K; d.k0 = 64 * (item / nblk); d.n0 = 32 * (item % nblk); d.fp8 = fp8; return d; };
        auto decode = [&](int it) {
            int r = it;
            if (r < I_G8) return mk(p.w_in + 4096, 7168, 3072, p.g1, ws + OFF_WG8, 1024, 1, r); r -= I_G8;
            if (r < I_IN) return mk(p.w_in, 7168, 4096, p.g1, ws + OFF_WINT, 1024, 0, r); r -= I_IN;
            if (r < I_Q) return mk(p.w_q, 2048, 2048, p.g2, ws + OFF_WQT, 1024, 0, r); r -= I_Q;
            if (r < I_KV) return mk(p.w_kv, 2048, 2048, nullptr, ws + OFF_WKVT, 1024, 0, r); r -= I_KV;
            if (r < I_SQ) return mk(p.w_so, 1024, 1024, nullptr, ws + OFF_WSOT, 1024, 0, r); r -= I_SQ;
            if (r < I_SQ) return mk(p.w_xo, 1024, 1024, nullptr, ws + OFF_WXOT, 1024, 0, r); r -= I_SQ;
            if (r < I_SQ) return mk(p.w_out, 1024, 1024, nullptr, ws + OFF_WOUTT, 1024, 0, r); r -= I_SQ;
            const int g = r / I_PL; return mk(p.pool_w + (size_t)g * 65536, 256, 256, nullptr, ws + OFF_POOLT + (size_t)g * 65536 * 2, 256, 0, r % I_PL); };
        int it = gwave(); const int nw = nwaves();
        if (it < NIT) {
            TItem dn = decode(it); float vn[32]; float4 sn0, sn1;
            titem_load(dn, lane, vn, sn0, sn1);
            for (; it < NIT; it += nw) {
                const TItem dc = dn; float v[32]; const float4 s0 = sn0, s1 = sn1;
#pragma unroll
                for (int i = 0; i < 32; ++i) v[i] = vn[i];
                if (it + nw < NIT) { dn = decode(it + nw); titem_load(dn, lane, vn, sn0, sn1); }
                titem_finish(dc, scr, lane, v, s0, s1);
            }
        }
    }
    { bf16_t* kb = (bf16_t*)(ws + OFF_KEYB);
      for (int i = blockIdx.x * NTHREADS + tidx(); i < 2 * 128 * 128; i += gridDim.x * NTHREADS) kb[i] = f2bf(i < 16384 ? p.k1[i] : p.k2[i - 16384]); }
    bf16_t* wm = (bf16_t*)(ws + OFF_WM);
    for (int i = blockIdx.x * NTHREADS + tidx(); i < 8 * 128 * 128; i += gridDim.x * NTHREADS) {
        const int t = (i >> 7) & 127, s = i & 127;
        wm[i] = f2bf(s <= t ? p.w_s[i] : 0.f);
    }
}

__device__ __forceinline__ void p1_g1(const Params& p, float* stg, PG8_LAS unsigned char* ldsp) {
    unsigned char* ws = p.ws;
    {
        const bf16_t* XB = (const bf16_t*)((unsigned char*)p.out + OUT_XB); const bf16_t* WinT = (const bf16_t*)(ws + OFF_WINT); const float* rs1 = (const float*)(ws + OFF_RS1);
        const size_t tb = (size_t)256 * 1024 * 2;
        pg8::StaticOrder S1; S1.init(T_TOK, 1024, gridDim.x, blockIdx.x);
        pg8::StaticOrder S3; S3.init(T_TOK, 3072, gridDim.x, blockIdx.x);
        { pg8::Gemm g{XB, WinT, 1024, 1024, 1024, tb, 0, tb}; pg8::EpiSeg<0> E{rs1, (bf16_t*)(ws + OFF_P), 1024}; pg8::gemm_phase(ldsp, g, S1, E); }
        { pg8::StaticOrder S2; S2.init(T_TOK, 2048, gridDim.x, blockIdx.x);
          pg8::Gemm g{XB, WinT + (size_t)1024 * 1024, 1024, 1024, 1024, tb, 0, tb}; pg8::EpiSeg<1> E{rs1, (bf16_t*)(ws + OFF_GU), 1024, 1.0f, (bf16_t*)(ws + OFF_GV), 4}; pg8::gemm_phase(ldsp, g, S2, E); }
        { pg8::Gemm g{XB, WinT + (size_t)3072 * 1024, 1024, 1024, 1024, tb, 0, tb}; pg8::EpiSeg<2> E{rs1, (bf16_t*)(ws + OFF_Q), 1024}; pg8::gemm_phase(ldsp, g, S1, E); }
        {
            pg8::Gemm g{(const bf16_t*)((unsigned char*)p.out + OUT_XB8), (const bf16_t*)(ws + OFF_WG8), 512, 512, 512, (size_t)256 * 1024, 0, (size_t)256 * 1024};
            pg8::EpiSeg<3> E{rs1, (bf16_t*)(ws + OFF_GATES), 3072, 1.0f / WG8_SCALE}; pg8::gemm_phase<pg8::EpiSeg<3>, pg8::StaticOrder, true>(ldsp, g, S3, E); }
    }
}


__device__ __forceinline__ void p1_kv(const Params& p, PG8_LAS unsigned char* ldsp, int nkv) {
    unsigned char* ws = p.ws;
    const bf16_t* MEMN = (const bf16_t*)(ws + OFF_MEMN); const bf16_t* WkvT = (const bf16_t*)(ws + OFF_WKVT);
    const size_t tb = (size_t)256 * 1024 * 2;
    const int half = nkv >> 1, c = blockIdx.x;
    if (nkv < 2 || c < half) {
        pg8::StaticOrder S; S.init(2048, 1024, nkv < 2 ? 1 : half, nkv < 2 ? 0 : c);
        pg8::Gemm g{MEMN, WkvT, 1024, 1024, 1024, tb, 0, tb}; pg8::EpiPlain E{(bf16_t*)(ws + OFF_KMAT), 1024}; pg8::gemm_phase(ldsp, g, S, E);
    }
    if (nkv < 2 || c >= half) {
        pg8::StaticOrder S; S.init(1024, 2048, nkv < 2 ? 1 : nkv - half, nkv < 2 ? 0 : c - half);
        pg8::Gemm g{WkvT + (size_t)1024 * 1024, MEMN, 1024, 1024, 1024, tb, 0, tb}; pg8::EpiPlain E{(bf16_t*)(ws + OFF_VT), 2048}; pg8::gemm_phase(ldsp, g, S, E);
    }
}

typedef short s16x4 __attribute__((ext_vector_type(4)));
__device__ __forceinline__ unsigned offb(unsigned row, unsigned ch) { return 256u * row + 16u * (ch ^ (((row & 3) << 2) | ((row >> 2) & 3))); }
__device__ __forceinline__ unsigned tr_addr16(unsigned lane, unsigned c, unsigned ks, unsigned t) {
    const unsigned g = lane >> 4, q = (lane & 15) >> 2, p = lane & 3;
    return offb(32 * ks + 8 * g + 4 * t + q, 2 * c + (p >> 1)) + 8 * (p & 1);
}
#define SGU_TILE_OFF 0
#define SGU_STAT_OFF 32768
#define SGU_STG_OFF  34816
#define SGU_STG_STRIDE 132
__device__ __forceinline__ void sgu_unit(const Params& p, unsigned char* smem, int bc) {
    unsigned char* ws = p.ws;
    const bf16_t* GV = (const bf16_t*)(ws + OFF_GV); bf16_t* GU = (bf16_t*)(ws + OFF_GU); const bf16_t* WM = (const bf16_t*)(ws + OFF_WM);
    const int tid = tidx(), lane = tid & 63, wid = tid >> 6, r = lane & 15, g = lane >> 4;
    float* stats = (float*)(smem + SGU_STAT_OFF);
    float* stg = (float*)(smem + SGU_STG_OFF) + wid * (16 * SGU_STG_STRIDE);
    const unsigned tile_base = (unsigned)(size_t)(smem + SGU_TILE_OFF);
#pragma unroll 1
    for (int hb = 0; hb < 2; ++hb) {
        uint4 r0[8], r1[8];
#pragma unroll
        for (int i = 0; i < 8; ++i) { const bf16_t* row = GV + ((size_t)bc * 128 + wid * 16 + hb * 8 + i) * DM; r0[i] = *(const uint4*)(row + lane * 8); r1[i] = *(const uint4*)(row + 512 + lane * 8); }
#pragma unroll
        for (int i = 0; i < 8; ++i) {
            const int tok = wid * 16 + hb * 8 + i;
            const unsigned ww[8] = {r0[i].x, r0[i].y, r0[i].z, r0[i].w, r1[i].x, r1[i].y, r1[i].z, r1[i].w};
            float v[16], s1 = 0.f;
#pragma unroll
            for (int k = 0; k < 8; ++k) { v[2 * k] = __uint_as_float(ww[k] << 16); v[2 * k + 1] = __uint_as_float(ww[k] & 0xffff0000u); s1 += v[2 * k] + v[2 * k + 1]; }
            const float mu = wave_sum(s1) * (1.0f / DM);
            float s2 = 0.f;
#pragma unroll
            for (int k = 0; k < 16; ++k) { const float d = v[k] - mu; s2 += d * d; }
            const float rstd = rsqrtf(wave_sum(s2) * (1.0f / DM) + 1e-5f);
            if (lane == 0) { stats[2 * tok] = mu; stats[2 * tok + 1] = rstd; }
        }
    }
    const int ch = tid & 15;
    uint4 gvn[4];
#pragma unroll
    for (int i = 0; i < 4; ++i) gvn[i] = *(const uint4*)(GV + ((size_t)bc * 128 + (tid >> 4) + 32 * i) * DM + ch * 8);
    float4 g0n = *(const float4*)(p.ln_g + ch * 8), g1n = *(const float4*)(p.ln_g + ch * 8 + 4), b0n = *(const float4*)(p.ln_b + ch * 8), b1n = *(const float4*)(p.ln_b + ch * 8 + 4);
    bf16x8 an[4];
#pragma unroll
    for (int ks = 0; ks < 4; ++ks) an[ks] = *(const bf16x8*)(WM + (size_t)(wid * 16 + r) * 128 + ks * 32 + g * 8);
    float bsn[4];
#pragma unroll
    for (int k = 0; k < 4; ++k) bsn[k] = p.b_s[wid * 16 + 4 * k + (lane >> 4)];
    __syncthreads();
#pragma unroll 1
    for (int h = 0; h < 8; ++h) {
        const float4 g0 = g0n, g1 = g1n, b0 = b0n, b1 = b1n;
        bf16x8 a[4];
#pragma unroll
        for (int ks = 0; ks < 4; ++ks) a[ks] = an[ks];
        float bs[4];
#pragma unroll
        for (int k = 0; k < 4; ++k) bs[k] = bsn[k];
        {
            const float gg[8] = {g0.x, g0.y, g0.z, g0.w, g1.x, g1.y, g1.z, g1.w}, bb[8] = {b0.x, b0.y, b0.z, b0.w, b1.x, b1.y, b1.z, b1.w};
#pragma unroll
            for (int i = 0; i < 4; ++i) {
                const int sr = (tid >> 4) + 32 * i;
                const uint4 w = gvn[i];
                const float mu = stats[2 * sr], rstd = stats[2 * sr + 1];
                const unsigned ww[4] = {w.x, w.y, w.z, w.w}; unsigned o[4];
#pragma unroll
                for (int k = 0; k < 4; ++k) {
                    const float x0 = (__uint_as_float(ww[k] << 16) - mu) * rstd * gg[2 * k] + bb[2 * k], x1 = (__uint_as_float(ww[k] & 0xffff0000u) - mu) * rstd * gg[2 * k + 1] + bb[2 * k + 1];
                    o[k] = pack2(x0, x1);
                }
                uint4 ov; ov.x = o[0]; ov.y = o[1]; ov.z = o[2]; ov.w = o[3];
                *(uint4*)(smem + SGU_TILE_OFF + offb(sr, ch)) = ov;
            }
        }
        __syncthreads();
        if (h < 7) {
#pragma unroll
            for (int i = 0; i < 4; ++i) gvn[i] = *(const uint4*)(GV + ((size_t)bc * 128 + (tid >> 4) + 32 * i) * DM + (h + 1) * 128 + ch * 8);
            g0n = *(const float4*)(p.ln_g + (h + 1) * 128 + ch * 8); g1n = *(const float4*)(p.ln_g + (h + 1) * 128 + ch * 8 + 4);
            b0n = *(const float4*)(p.ln_b + (h + 1) * 128 + ch * 8); b1n = *(const float4*)(p.ln_b + (h + 1) * 128 + ch * 8 + 4);
#pragma unroll
            for (int ks = 0; ks < 4; ++ks) an[ks] = *(const bf16x8*)(WM + (size_t)(h + 1) * 16384 + (size_t)(wid * 16 + r) * 128 + ks * 32 + g * 8);
#pragma unroll
            for (int k = 0; k < 4; ++k) bsn[k] = p.b_s[(h + 1) * 128 + wid * 16 + 4 * k + (lane >> 4)];
        }
        const int er = lane >> 4, ec = (lane & 15) * 8;
        bf16_t* gp = GU + ((size_t)bc * 128 + wid * 16 + er) * DM + h * 128 + ec;
        uint4 guk[4];
#pragma unroll
        for (int k = 0; k < 4; ++k) guk[k] = *(const uint4*)(gp + (size_t)(4 * k) * DM);
        f32x4 acc[8];
#pragma unroll
        for (int c = 0; c < 8; ++c) acc[c] = (f32x4){0.f, 0.f, 0.f, 0.f};
#pragma unroll
        for (int c = 0; c < 8; ++c) {
            s16x4 q0, q1, q2, q3, q4, q5, q6, q7;
            asm volatile("ds_read_b64_tr_b16 %0, %8\n\tds_read_b64_tr_b16 %1, %9\n\tds_read_b64_tr_b16 %2, %10\n\tds_read_b64_tr_b16 %3, %11\n\t"
                         "ds_read_b64_tr_b16 %4, %12\n\tds_read_b64_tr_b16 %5, %13\n\tds_read_b64_tr_b16 %6, %14\n\tds_read_b64_tr_b16 %7, %15\n\ts_waitcnt lgkmcnt(0)"
                         : "=&v"(q0), "=&v"(q1), "=&v"(q2), "=&v"(q3), "=&v"(q4), "=&v"(q5), "=&v"(q6), "=&v"(q7)
                         : "v"(tile_base + tr_addr16(lane, c, 0, 0)), "v"(tile_base + tr_addr16(lane, c, 0, 1)), "v"(tile_base + tr_addr16(lane, c, 1, 0)), "v"(tile_base + tr_addr16(lane, c, 1, 1)),
                           "v"(tile_base + tr_addr16(lane, c, 2, 0)), "v"(tile_base + tr_addr16(lane, c, 2, 1)), "v"(tile_base + tr_addr16(lane, c, 3, 0)), "v"(tile_base + tr_addr16(lane, c, 3, 1))
                         : "memory");
            __builtin_amdgcn_sched_barrier(0);
            const bf16x8 b0 = {q0[0], q0[1], q0[2], q0[3], q1[0], q1[1], q1[2], q1[3]}, b1 = {q2[0], q2[1], q2[2], q2[3], q3[0], q3[1], q3[2], q3[3]};
            const bf16x8 b2 = {q4[0], q4[1], q4[2], q4[3], q5[0], q5[1], q5[2], q5[3]}, b3 = {q6[0], q6[1], q6[2], q6[3], q7[0], q7[1], q7[2], q7[3]};
            acc[c] = __builtin_amdgcn_mfma_f32_16x16x32_bf16(a[0], b0, acc[c], 0, 0, 0);
            acc[c] = __builtin_amdgcn_mfma_f32_16x16x32_bf16(a[1], b1, acc[c], 0, 0, 0);
            acc[c] = __builtin_amdgcn_mfma_f32_16x16x32_bf16(a[2], b2, acc[c], 0, 0, 0);
            acc[c] = __builtin_amdgcn_mfma_f32_16x16x32_bf16(a[3], b3, acc[c], 0, 0, 0);
        }
#pragma unroll
        for (int c = 0; c < 8; ++c)
#pragma unroll
            for (int j = 0; j < 4; ++j) stg[(4 * g + j) * SGU_STG_STRIDE + 16 * c + r] = acc[c][j];
        __builtin_amdgcn_wave_barrier(); asm volatile("s_waitcnt lgkmcnt(0)" ::: "memory");
#pragma unroll
        for (int k = 0; k < 4; ++k) {
            const float* sp = stg + (4 * k + er) * SGU_STG_STRIDE + ec;
            const float4 t0 = *(const float4*)sp, t1 = *(const float4*)(sp + 4);
            const float v[8] = {t0.x, t0.y, t0.z, t0.w, t1.x, t1.y, t1.z, t1.w};
            const unsigned gw[4] = {guk[k].x, guk[k].y, guk[k].z, guk[k].w};
            uint4 o; unsigned ow[4];
#pragma unroll
            for (int j = 0; j < 4; ++j) ow[j] = pack2(__uint_as_float(gw[j] << 16) * (v[2 * j] + bs[k]), __uint_as_float(gw[j] & 0xffff0000u) * (v[2 * j + 1] + bs[k]));
            o.x = ow[0]; o.y = ow[1]; o.z = ow[2]; o.w = ow[3];
            *(uint4*)(gp + (size_t)(4 * k) * DM) = o;
        }
        asm volatile("s_waitcnt lgkmcnt(0)" ::: "memory");
        __syncthreads();
    }
}
__device__ __forceinline__ void p3_sgu(const Params& p, unsigned char* smem) {
    for (int bc = blockIdx.x; bc < 256; bc += gridDim.x) sgu_unit(p, smem, bc);
}


template <int WIN> __device__ __forceinline__ void pool_load(const unsigned* __restrict__ P32, int wd, int t0, unsigned (&v)[48]) {
    const int s0 = t0 & (SEQ - 1);
#pragma unroll
    for (int k = 0; k < 16; ++k) v[k] = (k >= 17 - WIN) ? ((s0 - 16 + k >= 0) ? P32[(size_t)(t0 - 16 + k) * 512 + wd] : 0u) : 0u;
#pragma unroll
    for (int k = 0; k < 32; ++k) v[16 + k] = P32[(size_t)(t0 + k) * 512 + wd];
}
template <int WIN> __device__ __forceinline__ void pool_compute(unsigned* __restrict__ D32, int wd, int t0, const unsigned (&v)[48]) {
    const int s0 = t0 & (SEQ - 1);
    float slo = 0.f, shi = 0.f;
#pragma unroll
    for (int k = 17 - WIN; k < 16; ++k) { slo += __uint_as_float(v[k] << 16); shi += __uint_as_float(v[k] & 0xffff0000u); }
#pragma unroll
    for (int i = 0; i < 32; ++i) {
        const float plo = __uint_as_float(v[16 + i] << 16), phi = __uint_as_float(v[16 + i] & 0xffff0000u);
        slo += plo; shi += phi;
        const int sq = s0 + i;
        const float inv = 1.0f / (float)(sq + 1 < WIN ? sq + 1 : WIN);
        D32[(size_t)(t0 + i) * 512 + wd] = pack2(slo * inv - plo, shi * inv - phi);
        slo -= __uint_as_float(v[16 + i - WIN + 1] << 16); shi -= __uint_as_float(v[16 + i - WIN + 1] & 0xffff0000u);
    }
}
template <int WIN> __device__ __forceinline__ void pool_run(const unsigned* __restrict__ P32, unsigned* __restrict__ D32, int item, int stride, int nitems) {
    const int wd = item & 511;
    unsigned vn[48];
    pool_load<WIN>(P32, wd, (item >> 9) * 32, vn);
    for (; item < nitems; item += stride) {
        unsigned v[48];
#pragma unroll
        for (int k = 0; k < 48; ++k) v[k] = vn[k];
        if (item + stride < nitems) pool_load<WIN>(P32, wd, ((item + stride) >> 9) * 32, vn);
        pool_compute<WIN>(D32, wd, (item >> 9) * 32, v);
    }
}
__device__ __forceinline__ void p2_pool(const Params& p) {
    const unsigned* P32 = (const unsigned*)(p.ws + OFF_P); unsigned* D32 = (unsigned*)((unsigned char*)p.out + OUT_DIFF);
    const int item = blockIdx.x * NTHREADS + tidx(), stride = gridDim.x * NTHREADS, nitems = (T_TOK / 32) * 512;
    if (item >= nitems) return;
    const int g = __builtin_amdgcn_readfirstlane((item & 511) >> 7);
    if (g == 0) pool_run<2>(P32, D32, item, stride, nitems); else if (g == 1) pool_run<4>(P32, D32, item, stride, nitems);
    else if (g == 2) pool_run<8>(P32, D32, item, stride, nitems); else pool_run<16>(P32, D32, item, stride, nitems);
}
__device__ __forceinline__ void p2_attn(const Params& p, PG8_LAS unsigned char* ldsp) {
    unsigned char* ws = p.ws;
    bf16_t* QPO = (bf16_t*)(ws + OFF_Q); float* LSP = (float*)(ws + OFF_LSP);
    pg8::StaticOrder S; S.init(T_TOK, 1024, gridDim.x, blockIdx.x);
    {
        pg8::Gemm g{QPO, (const bf16_t*)(ws + OFF_KMAT), 1024, 1024, 256, (size_t)256 * 1024 * 2, (size_t)512, (size_t)512, (size_t)256 * 1024 * 2, 4};
        pg8::EpiS E{QPO, LSP}; pg8::gemm_phase(ldsp, g, S, E);
    }
    asm volatile("s_waitcnt vmcnt(0)" ::: "memory"); __builtin_amdgcn_fence(__ATOMIC_ACQUIRE, "agent"); asm volatile("s_waitcnt vmcnt(0)" ::: "memory"); __syncthreads();
    {
        pg8::Gemm g{QPO, (const bf16_t*)(ws + OFF_VT), 1024, 2048, 256, (size_t)256 * 1024 * 2, (size_t)512, (size_t)256 * 2048 * 2, (size_t)512, 4};
        pg8::EpiPV E{QPO, LSP}; pg8::gemm_phase(ldsp, g, S, E);
    }
}

__device__ __forceinline__ void p4(const Params& p, PG8_LAS unsigned char* ldsp) {
    unsigned char* ws = p.ws;
    const unsigned char* GATES = (const unsigned char*)(ws + OFF_GATES); bf16_t* MERGED = (bf16_t*)(ws + OFF_MERGED);
    pg8::StaticOrder S; S.init(T_TOK, 1024, gridDim.x, blockIdx.x);
    {
        pg8::Gemm g{(const bf16_t*)(ws + OFF_GU), (const bf16_t*)(ws + OFF_WSOT), 1024, 1024, 1024, (size_t)256 * 1024 * 2, 0, (size_t)256 * 1024 * 2};
        pg8::EpiMerged<0> E{GATES, MERGED, p.pool_scale}; pg8::gemm_phase(ldsp, g, S, E);
    }
    {
        pg8::Gemm g{(const bf16_t*)(ws + OFF_O), (const bf16_t*)(ws + OFF_WXOT), 1024, 1024, 1024, (size_t)256 * 1024 * 2, 0, (size_t)256 * 1024 * 2};
        pg8::EpiMerged<1> E{GATES, MERGED, p.pool_scale}; pg8::gemm_phase(ldsp, g, S, E);
    }
    {
        pg8::Gemm g{(const bf16_t*)((unsigned char*)p.out + OUT_DIFF), (const bf16_t*)(ws + OFF_POOLT), 1024, 256, 256, (size_t)256 * 1024 * 2, (size_t)256 * 2, (size_t)256 * 256 * 2};
        pg8::EpiMerged<2> E{GATES, MERGED, p.pool_scale}; pg8::gemm_phase(ldsp, g, S, E);
    }
}
__device__ __forceinline__ void p5(const Params& p, PG8_LAS unsigned char* ldsp) {
    unsigned char* ws = p.ws;
    {
        pg8::Gemm g{(const bf16_t*)(ws + OFF_MERGED), (const bf16_t*)(ws + OFF_WOUTT), 1024, 1024, 1024, (size_t)256 * 1024 * 2, 0, (size_t)256 * 1024 * 2};
        pg8::StaticOrder S; S.init(T_TOK, 1024, gridDim.x, blockIdx.x);
        pg8::EpiH E{(const bf16_t*)((unsigned char*)p.out + OUT_XB), (bf16_t*)(ws + OFF_HB), (float*)(ws + OFF_SSQP)}; pg8::gemm_phase(ldsp, g, S, E);
    }
}
__device__ __forceinline__ void p6(const Params& p, PG8_LAS unsigned char* ldsp) {
    unsigned char* ws = p.ws;
    pg8::Gemm g{(const bf16_t*)(ws + OFF_HB), (const bf16_t*)(ws + OFF_WQT), 1024, 1024, 1024, (size_t)256 * 1024 * 2, 0, (size_t)256 * 1024 * 2};
    pg8::StaticOrder S; S.init(T_TOK, 2048, gridDim.x, blockIdx.x);
    {
        const float* SSQP = (const float*)(ws + OFF_SSQP); float* RS2 = (float*)(ws + OFF_RS2);
        const int tid = tidx();
        pg8::Unit un;
        for (int i = 0; S.next(i, un); ++i)
            if (tid < 256) {
                const int row = un.pm * 256 + tid;
                const f32x4* pp = (const f32x4*)(SSQP + (size_t)row * 64);
                f32x4 a = pp[0];
#pragma unroll
                for (int k = 1; k < 16; ++k) a += pp[k];
                RS2[row] = rsqrtf(((a[0] + a[1]) + (a[2] + a[3])) * (1.0f / DM) + 1e-6f);
            }
        asm volatile("s_waitcnt vmcnt(0)" ::: "memory"); __syncthreads();
    }
    pg8::EpiQ2 E{(const float*)(ws + OFF_RS2), (bf16_t*)(ws + OFF_GATES)}; pg8::gemm_phase(ldsp, g, S, E);
}

#define KMIN ((int)0x80000000)
__device__ __forceinline__ void ce_desc(int& a, int& b) { const int hi = a > b ? a : b, lo = a > b ? b : a; a = hi; b = lo; }
template <int N> __device__ __forceinline__ void bitonic_sort_desc(int (&x)[N]) {
#pragma unroll
    for (int k = 2; k <= N; k <<= 1)
#pragma unroll
        for (int j = k >> 1; j > 0; j >>= 1)
#pragma unroll
            for (int i = 0; i < N; ++i) { const int l = i ^ j; if (l > i) { if ((i & k) == 0) ce_desc(x[i], x[l]); else ce_desc(x[l], x[i]); } }
}
__device__ __forceinline__ void merge_top16(int (&a)[16], const int (&b)[16]) {
#pragma unroll
    for (int i = 0; i < 16; ++i) a[i] = a[i] > b[15 - i] ? a[i] : b[15 - i];
#pragma unroll
    for (int j = 8; j > 0; j >>= 1)
#pragma unroll
        for (int i = 0; i < 16; ++i) { const int l = i ^ j; if (l > i) ce_desc(a[i], a[l]); }
}
__device__ __forceinline__ int enc_f(unsigned u) { return (int)(u ^ ((unsigned)((int)u >> 31) & 0x7fffffffu)); }
__device__ __forceinline__ float sortkey_val(int key, unsigned mask) { return __uint_as_float((unsigned)enc_f((unsigned)key & ~mask)); }
__device__ __forceinline__ int bfi_low(unsigned mask, unsigned lowbits, unsigned x) { unsigned r; asm("v_bfi_b32 %0, %1, %2, %3" : "=v"(r) : "s"(mask), "v"(lowbits), "v"(x)); return (int)r; }
__device__ __forceinline__ int pack7(float score, unsigned idx) { return bfi_low(127u, idx, (unsigned)enc_f(__float_as_uint(score))); }
__device__ __forceinline__ int pack8(float sum, unsigned code) { return bfi_low(255u, code, (unsigned)enc_f(__float_as_uint(sum))); }
__device__ __forceinline__ void sort16_desc(int (&x)[16]) {
    ce_desc(x[0], x[1]); ce_desc(x[2], x[3]); ce_desc(x[0], x[2]); ce_desc(x[1], x[3]); ce_desc(x[1], x[2]); ce_desc(x[4], x[5]); ce_desc(x[6], x[7]); ce_desc(x[4], x[6]); ce_desc(x[5], x[7]); ce_desc(x[5], x[6]); ce_desc(x[0], x[4]); ce_desc(x[2], x[6]); ce_desc(x[2], x[4]); ce_desc(x[1], x[5]); ce_desc(x[3], x[7]); ce_desc(x[3], x[5]); ce_desc(x[1], x[2]); ce_desc(x[3], x[4]); ce_desc(x[5], x[6]); ce_desc(x[8], x[9]); ce_desc(x[10], x[11]); ce_desc(x[8], x[10]); ce_desc(x[9], x[11]); ce_desc(x[9], x[10]); ce_desc(x[12], x[13]); ce_desc(x[14], x[15]); ce_desc(x[12], x[14]); ce_desc(x[13], x[15]); ce_desc(x[13], x[14]); ce_desc(x[8], x[12]); ce_desc(x[10], x[14]); ce_desc(x[10], x[12]); ce_desc(x[9], x[13]); ce_desc(x[11], x[15]); ce_desc(x[11], x[13]); ce_desc(x[9], x[10]); ce_desc(x[11], x[12]); ce_desc(x[13], x[14]); ce_desc(x[0], x[8]); ce_desc(x[4], x[12]); ce_desc(x[4], x[8]); ce_desc(x[2], x[10]); ce_desc(x[6], x[14]); ce_desc(x[6], x[10]); ce_desc(x[2], x[4]); ce_desc(x[6], x[8]); ce_desc(x[10], x[12]); ce_desc(x[1], x[9]); ce_desc(x[5], x[13]); ce_desc(x[5], x[9]); ce_desc(x[3], x[11]); ce_desc(x[7], x[15]); ce_desc(x[7], x[11]); ce_desc(x[3], x[5]); ce_desc(x[7], x[9]); ce_desc(x[11], x[13]); ce_desc(x[1], x[2]); ce_desc(x[3], x[4]); ce_desc(x[5], x[6]); ce_desc(x[7], x[8]); ce_desc(x[9], x[10]); ce_desc(x[11], x[12]); ce_desc(x[13], x[14]);
}
__device__ __forceinline__ void top16_of_32(int (&lo)[16], int (&hi)[16]) { sort16_desc(lo); sort16_desc(hi); merge_top16(lo, hi); }
template <int N> __device__ __forceinline__ void bitonic_merge_desc(int (&c)[N]) {
#pragma unroll
    for (int j = N >> 1; j > 0; j >>= 1)
#pragma unroll
        for (int i = 0; i < N; ++i) { const int l = i ^ j; if (l > i) ce_desc(c[i], c[l]); }
}
#define PK2(a, b) pack8(v1[a] + v2[b], 255u - (unsigned)((a) * 16 + (b)))
__device__ __forceinline__ void peer_level2(const int (&L1)[16], const int (&L2)[16], int (&w)[16]) {
    float v1[16], v2[16];
#pragma unroll
    for (int i = 0; i < 16; ++i) { v1[i] = sortkey_val(L1[i], 127u); v2[i] = sortkey_val(L2[i], 127u); }
    int T[16], C0[16];
#pragma unroll
    for (int i = 0; i < 16; ++i) T[i] = PK2(0, i);
#pragma unroll
    for (int i = 0; i < 15; ++i) C0[i] = PK2(i + 1, 0);
    C0[15] = KMIN;
    merge_top16(T, C0);
    int Y[8] = {PK2(2, 1), PK2(2, 2), PK2(2, 3), PK2(2, 4), KMIN, PK2(3, 3), PK2(3, 2), PK2(3, 1)};
    bitonic_merge_desc<8>(Y);
    int A[16] = {PK2(1, 1), PK2(1, 2), PK2(1, 3), PK2(1, 4), PK2(1, 5), PK2(1, 6), PK2(1, 7), KMIN, Y[7], Y[6], Y[5], Y[4], Y[3], Y[2], Y[1], Y[0]};
    bitonic_merge_desc<16>(A);
    merge_top16(T, A);
    int B[8] = {PK2(4, 1), PK2(4, 2), KMIN, KMIN, KMIN, PK2(7, 1), PK2(6, 1), PK2(5, 1)};
    bitonic_merge_desc<8>(B);
#pragma unroll
    for (int i = 8; i < 16; ++i) T[i] = T[i] > B[15 - i] ? T[i] : B[15 - i];
    bitonic_merge_desc<16>(T);
#pragma unroll
    for (int i = 0; i < 16; ++i) w[i] = T[i];
}
#undef PK2


__device__ __forceinline__ float wave_max(float v) {
#pragma unroll
    for (int o = 32; o > 0; o >>= 1) v = fmaxf(v, __shfl_xor(v, o, 64));
    return v;
}
__device__ __forceinline__ unsigned pack_i8x4(float a, float b, float c, float d, float inv) {
    const unsigned ya = __float_as_uint(fmaf(a, inv, 12582912.0f)), yb = __float_as_uint(fmaf(b, inv, 12582912.0f));
    const unsigned yc = __float_as_uint(fmaf(c, inv, 12582912.0f)), yd = __float_as_uint(fmaf(d, inv, 12582912.0f));
    const unsigned t01 = __builtin_amdgcn_perm(yb, ya, 0x00000400u), t23 = __builtin_amdgcn_perm(yd, yc, 0x00000400u);
    return __builtin_amdgcn_perm(t23, t01, 0x05040100u);
}
__device__ __forceinline__ void tabrow_load(const float* __restrict__ tab, int e, int lane, float4 (&a)[4]) {
#pragma unroll
    for (int i = 0; i < 4; ++i) a[i] = ldnt_f4(tab + (size_t)e * 1024 + 4 * lane + 256 * i);
}
__device__ __forceinline__ void tabrow_store(const float* __restrict__ gain, unsigned char* __restrict__ dst, float* __restrict__ scl, int e, int lane, float4 (&a)[4]) {
    float am = 0.f;
#pragma unroll
    for (int i = 0; i < 4; ++i) { if (gain) { const float4 g = *(const float4*)(gain + 4 * lane + 256 * i); a[i].x *= g.x; a[i].y *= g.y; a[i].z *= g.z; a[i].w *= g.w; }
        am = fmaxf(am, fmaxf(fmaxf(fabsf(a[i].x), fabsf(a[i].y)), fmaxf(fabsf(a[i].z), fabsf(a[i].w)))); }
    am = wave_max(am);
    const float inv = am > 0.f ? 127.0f / am : 0.f;
#pragma unroll
    for (int i = 0; i < 4; ++i)
        *(unsigned*)(dst + ((size_t)(2 * i + (lane >> 5)) << 21) + ((size_t)e << 7) + ((4 * lane) & 127)) = pack_i8x4(a[i].x, a[i].y, a[i].z, a[i].w, inv);
    if (lane == 0) scl[e] = am * (1.0f / 127.0f);
}
__device__ __forceinline__ void tab_convert(const Params& p, int wave0, int nw) {
    const int lane = tidx() & 63;
    int e = wave0; float4 un[4];
    if (e < 32768) tabrow_load(e < 16384 ? p.pu : p.pv, e & 16383, lane, un);
    for (; e < 32768; e += nw) {
        float4 uc[4];
#pragma unroll
        for (int i = 0; i < 4; ++i) uc[i] = un[i];
        const int en = e + nw;
        if (en < 32768) tabrow_load(en < 16384 ? p.pu : p.pv, en & 16383, lane, un);
        if (e < 16384) tabrow_store(p.g2, p.ws + OFF_UT8, (float*)(p.ws + OFF_US), e, lane, uc);
        else tabrow_store(nullptr, p.ws + OFF_VT8, (float*)(p.ws + OFF_VS), e - 16384, lane, uc);
    }
}
__device__ __forceinline__ void p7a_topk(const Params& p, unsigned char* smem) {
    unsigned char* ws = p.ws;
    const bf16_t* Q2 = (const bf16_t*)(ws + OFF_GATES); const bf16_t* KEYB = (const bf16_t*)(ws + OFF_KEYB);
    unsigned short* EX = (unsigned short*)(ws + OFF_EX); float* GT = (float*)(ws + OFF_GT); float* SE = (float*)(ws + OFF_SE); const float* US = (const float*)(ws + OFF_US); const float* VS = (const float*)(ws + OFF_VS);
    const int tid = tidx(), lane = tid & 63, wid = tid >> 6, q = lane >> 4, r = lane & 15;
#pragma unroll
    for (int i = 0; i < 8; ++i) {
        const int id = tid + NTHREADS * i, half = id >> 11, key = (id >> 4) & 127, c = id & 15;
        *(uint4*)(smem + half * 32768 + key * 256 + ((c ^ (key & 15)) << 4)) = *(const uint4*)(KEYB + (size_t)id * 8);
    }
    __syncthreads();
    unsigned char* idxs = smem + 65536 + wid * 2048 + lane * 32;
    bf16x8 bqn[2][4];
    {
        const int g0 = gwave() < T_TOK / 16 ? gwave() : 0;
#pragma unroll
        for (int half = 0; half < 2; ++half)
#pragma unroll
            for (int ks = 0; ks < 4; ++ks) bqn[half][ks] = *(const bf16x8*)(Q2 + (size_t)(g0 * 16 + r) * 2048 + half * 128 + ks * 32 + q * 8);
    }
    for (int grp = gwave(); grp < T_TOK / 16; grp += nwaves()) {
        const int t0 = grp * 16;
#pragma unroll 1
        for (int hh = 0; hh < 2; ++hh) {
            int Lk[2][16];
#pragma unroll
            for (int i = 0; i < 16; ++i) { Lk[0][i] = KMIN; Lk[1][i] = KMIN; }
#pragma unroll 1
            for (int j = 0; j < 4; ++j) {
                const int h = 4 * hh + j;
                bf16x8 bq[2][4];
#pragma unroll
                for (int half = 0; half < 2; ++half)
#pragma unroll
                    for (int ks = 0; ks < 4; ++ks) bq[half][ks] = bqn[half][ks];
                {
                    const int hn = (h + 1) & 7; int gn = (h == 7) ? grp + nwaves() : grp; if (gn >= T_TOK / 16) gn = grp;
                    const int rq = tidx() & 15, qq = (tidx() & 63) >> 4;
#pragma unroll
                    for (int half = 0; half < 2; ++half)
#pragma unroll
                        for (int ks = 0; ks < 4; ++ks) bqn[half][ks] = *(const bf16x8*)(Q2 + (size_t)(gn * 16 + rq) * 2048 + hn * 256 + half * 128 + ks * 32 + qq * 8);
                }
                const bool mine = ((tidx() & 63) >> 4) == j;
#pragma unroll
                for (int half = 0; half < 2; ++half) {
                    f32x4 acc[8];
                    bf16x8 kf[2][8];
#define P7A_KLOAD(buf, nb0) { _Pragma("unroll") for (int n2 = 0; n2 < 2; ++n2) _Pragma("unroll") for (int ks = 0; ks < 4; ++ks) \
        kf[buf][n2 * 4 + ks] = *(const bf16x8*)(smem + half * 32768 + (16 * ((nb0) + n2) + r) * 256 + (((4 * ks + q) ^ r) << 4)); }
                    P7A_KLOAD(0, 0);
#pragma unroll
                    for (int nbp = 0; nbp < 4; ++nbp) {
                        if (nbp < 3) { P7A_KLOAD((nbp + 1) & 1, 2 * (nbp + 1)); }
                        __builtin_amdgcn_sched_barrier(0);
#pragma unroll
                        for (int n2 = 0; n2 < 2; ++n2) {
                            const int nb = 2 * nbp + n2;
                            acc[nb] = (f32x4){0.f, 0.f, 0.f, 0.f};
#pragma unroll
                            for (int ks = 0; ks < 4; ++ks) acc[nb] = __builtin_amdgcn_mfma_f32_16x16x32_bf16(kf[nbp & 1][n2 * 4 + ks], bq[half][ks], acc[nb], 0, 0, 0);
                        }
                        __builtin_amdgcn_sched_barrier(0);
                    }
#undef P7A_KLOAD
                    int lo[16], hi[16], o[16];
#pragma unroll
                    for (int nb = 0; nb < 4; ++nb)
#pragma unroll
                        for (int jj = 0; jj < 4; ++jj) { lo[nb * 4 + jj] = pack7(acc[nb][jj], 16 * nb + 4 * q + jj); hi[nb * 4 + jj] = pack7(acc[nb + 4][jj], 16 * (nb + 4) + 4 * q + jj); }
                    top16_of_32(lo, hi);
#pragma unroll
                    for (int i = 0; i < 16; ++i) o[i] = __shfl_xor(lo[i], 16, 64);
                    merge_top16(lo, o);
#pragma unroll
                    for (int i = 0; i < 16; ++i) o[i] = __shfl_xor(lo[i], 32, 64);
                    merge_top16(lo, o);
#pragma unroll
                    for (int i = 0; i < 16; ++i) Lk[half][i] = mine ? lo[i] : Lk[half][i];
                }
            }
            const int hq = 4 * hh + q;
            int w[16]; peer_level2(Lk[0], Lk[1], w);
#pragma unroll
            for (int i4 = 0; i4 < 4; ++i4) {
                ((unsigned*)idxs)[i4] = ((unsigned)Lk[0][4 * i4] & 127u) | (((unsigned)Lk[0][4 * i4 + 1] & 127u) << 8) | (((unsigned)Lk[0][4 * i4 + 2] & 127u) << 16) | (((unsigned)Lk[0][4 * i4 + 3] & 127u) << 24);
                ((unsigned*)idxs)[4 + i4] = ((unsigned)Lk[1][4 * i4] & 127u) | (((unsigned)Lk[1][4 * i4 + 1] & 127u) << 8) | (((unsigned)Lk[1][4 * i4 + 2] & 127u) << 16) | (((unsigned)Lk[1][4 * i4 + 3] & 127u) << 24);
            }
            const float mx = sortkey_val(w[0], 255u);
            float ev[16], den = 0.f; unsigned ex[16];
#pragma unroll
            for (int k = 0; k < 16; ++k) {
                ev[k] = __expf(sortkey_val(w[k], 255u) - mx); den += ev[k];
                const unsigned code = 255u - ((unsigned)w[k] & 255u);
                ex[k] = (unsigned)idxs[code >> 4] * 128u + (unsigned)idxs[16 + (code & 15u)];
            }
            const float inv = 1.0f / den;
            float su[16], sv[16];
#pragma unroll
            for (int k = 0; k < 16; ++k) { su[k] = US[ex[k]]; sv[k] = VS[ex[k]] * (ev[k] * inv); }
            const size_t ob = (size_t)(t0 + r) * 128 + hq * 16;
            uint4 e0, e1;
            e0.x = ex[0] | (ex[1] << 16); e0.y = ex[2] | (ex[3] << 16); e0.z = ex[4] | (ex[5] << 16); e0.w = ex[6] | (ex[7] << 16);
            e1.x = ex[8] | (ex[9] << 16); e1.y = ex[10] | (ex[11] << 16); e1.z = ex[12] | (ex[13] << 16); e1.w = ex[14] | (ex[15] << 16);
            *(uint4*)(EX + ob) = e0; *(uint4*)(EX + ob + 8) = e1;
#pragma unroll
            for (int c = 0; c < 4; ++c) {
                *(float4*)(SE + ob + 4 * c) = make_float4(su[4 * c], su[4 * c + 1], su[4 * c + 2], su[4 * c + 3]);
                *(float4*)(GT + ob + 4 * c) = make_float4(sv[4 * c], sv[4 * c + 1], sv[4 * c + 2], sv[4 * c + 3]);
            }
        }
    }
}


#define XB_TMO      128
#define XB_XCNT(j)  (256  + 64 * (j))
#define XB_XSUB(j)  (1280 + 64 * (j))
#define XB_XGEN(j)  (2304 + 64 * (j))
#define XB_TOP      3328
#define XB_TOPGEN   3392
#define XCD_BAR_WORDS 3456
#define XB_SPIN_CAP (1u << 20)
#define LAS3 __attribute__((address_space(3)))
__device__ __forceinline__ unsigned xb_ld(unsigned* p)              { return __hip_atomic_load(p, __ATOMIC_RELAXED, __HIP_MEMORY_SCOPE_AGENT); }
__device__ __forceinline__ unsigned xb_add(unsigned* p, unsigned v) { return __hip_atomic_fetch_add(p, v, __ATOMIC_RELAXED, __HIP_MEMORY_SCOPE_AGENT); }
__device__ __forceinline__ unsigned xb_xcc_id() { return (unsigned)__builtin_amdgcn_s_getreg((3 << 11) | 20) & 0xFu; }
#define XB_SPIN(cond, bar) do { unsigned _sp = 0; while (cond) { __builtin_amdgcn_s_sleep(1); \
    if ((++_sp & 255u) == 0u) { if (xb_ld(&(bar)[XB_TMO])) break; if (_sp > XB_SPIN_CAP) { atomicAdd(&(bar)[XB_TMO], 1u); break; } } } } while (0)
struct XcdBarrier { unsigned* bar; unsigned x; volatile LAS3 unsigned* st; };
__device__ __forceinline__ XcdBarrier xcd_barrier_post(unsigned* bar, volatile LAS3 unsigned* st) {
    XcdBarrier b; b.bar = bar; b.x = xb_xcc_id(); b.st = st;
    if (threadIdx.x == 0) st[2] = xb_add(&bar[XB_XCNT(b.x)], 1u);
    return b;
}
__device__ __forceinline__ void xcd_barrier_complete(unsigned* bar, unsigned x, unsigned& nloc, unsigned& nx) {
    const unsigned G = gridDim.x * gridDim.y * gridDim.z;
    unsigned sum, cnt, mine, sp = 0u;
    for (;;) {
        sum = 0u; cnt = 0u; mine = 0u;
#pragma unroll
        for (unsigned j = 0; j < 16; ++j) { const unsigned c = xb_ld(&bar[XB_XCNT(j)]); sum += c; cnt += (c > 0u) ? 1u : 0u; mine = (j == x) ? c : mine; }
        if (sum == G) break;
        __builtin_amdgcn_s_sleep(1);
        if ((++sp & 255u) == 0u) { if (xb_ld(&bar[XB_TMO])) break; if (sp > XB_SPIN_CAP) { atomicAdd(&bar[XB_TMO], 1u); break; } }
    }
    nloc = mine > 0u ? mine : 1u; nx = cnt > 0u ? cnt : 1u;
}
__device__ __forceinline__ void xcd_barrier(const XcdBarrier& b) {
    asm volatile("s_waitcnt vmcnt(0)" ::: "memory");
    __syncthreads();
    if (threadIdx.x == 0) {
        unsigned* bar = b.bar;
        __builtin_amdgcn_s_waitcnt(0);
        unsigned nloc = b.st[0], nx = b.st[1];
        if (nloc == 0u) { xcd_barrier_complete(bar, b.x, nloc, nx); b.st[0] = nloc; b.st[1] = nx; }
        const unsigned old = xb_add(&bar[XB_XSUB(b.x)], 1u);
        const unsigned gen = old / nloc;
        if (old + 1u == (gen + 1u) * nloc) {
            __builtin_amdgcn_fence(__ATOMIC_RELEASE, "agent");
            asm volatile("s_waitcnt vmcnt(0)" ::: "memory");
            const unsigned og = xb_add(&bar[XB_TOP], 1u);
            const unsigned tg = og / nx;
            if (og + 1u == (tg + 1u) * nx) xb_add(&bar[XB_TOPGEN], 1u);
            else XB_SPIN(xb_ld(&bar[XB_TOPGEN]) == tg, bar);
            __builtin_amdgcn_fence(__ATOMIC_ACQUIRE, "agent");
            xb_add(&bar[XB_XGEN(b.x)], 1u);
            asm volatile("s_waitcnt vmcnt(0)" ::: "memory");
        } else {
            XB_SPIN(xb_ld(&bar[XB_XGEN(b.x)]) == gen, bar);
            __builtin_amdgcn_fence(__ATOMIC_ACQUIRE, "agent");
            asm volatile("s_waitcnt vmcnt(0)" ::: "memory");
        }
    }
    __syncthreads();
}


typedef float f32x2v __attribute__((ext_vector_type(2)));
typedef unsigned u32x4v __attribute__((ext_vector_type(4)));
struct XTopo { unsigned nloc, nx, rank, jx; };
__device__ __forceinline__ XTopo xcd_topology(const XcdBarrier& xb, volatile LAS3 unsigned* xst) {
    if (threadIdx.x == 0) { unsigned jx = 0;
#pragma unroll
        for (unsigned j = 0; j < 16; ++j) { const unsigned c = xb_ld(&xb.bar[XB_XCNT(j)]); jx += (j < xb.x && c > 0u) ? 1u : 0u; }
        xst[3] = jx; }
    __syncthreads();
    XTopo t; t.nloc = xst[0]; t.nx = xst[1]; t.rank = xst[2]; t.jx = xst[3];
    __syncthreads();
    return t;
}
#define SHARD_CVT(W_) const f32x2v c0_ = __builtin_amdgcn_cvt_pk_f32_fp8((int)(W_).x, false), c1_ = __builtin_amdgcn_cvt_pk_f32_fp8((int)(W_).x, true), c2_ = __builtin_amdgcn_cvt_pk_f32_fp8((int)(W_).y, false), c3_ = __builtin_amdgcn_cvt_pk_f32_fp8((int)(W_).y, true), \
        c4_ = __builtin_amdgcn_cvt_pk_f32_fp8((int)(W_).z, false), c5_ = __builtin_amdgcn_cvt_pk_f32_fp8((int)(W_).z, true), c6_ = __builtin_amdgcn_cvt_pk_f32_fp8((int)(W_).w, false), c7_ = __builtin_amdgcn_cvt_pk_f32_fp8((int)(W_).w, true);
__device__ __forceinline__ unsigned row_voff(unsigned w, int hi, unsigned cbase) {
    unsigned r;
    if (hi) asm("v_mad_u32_u16 %0, %1, %2, %3 op_sel:[1,0,0,0]" : "=v"(r) : "v"(w), "s"(128u), "v"(cbase));
    else asm("v_mad_u32_u16 %0, %1, %2, %3" : "=v"(r) : "v"(w), "s"(128u), "v"(cbase));
    return r;
}
#define ROW_VOFF(w, hi, cb) row_voff((w), (hi), (cb))
#define DPP_I(v, ctrl) __builtin_amdgcn_update_dpp(0, (int)(v), (ctrl), 0xF, 0xF, true)
#define DPP_XOR1 0xB1
#define DPP_XOR2 0x4E
#define DPP_HMIR 0x141
#define DPP_QREV 0x1B
#define DPP_ROR8 0x128
__device__ __forceinline__ float wave_max_nolds(float x) {
    x = fmaxf(x, __int_as_float(DPP_I(__float_as_int(x), DPP_XOR1))); x = fmaxf(x, __int_as_float(DPP_I(__float_as_int(x), DPP_XOR2)));
    x = fmaxf(x, __int_as_float(DPP_I(__float_as_int(x), DPP_HMIR))); x = fmaxf(x, __int_as_float(DPP_I(__float_as_int(x), DPP_ROR8)));
    { const auto r = __builtin_amdgcn_permlane16_swap(__float_as_uint(x), __float_as_uint(x), false, false); x = fmaxf(__uint_as_float(r[0]), __uint_as_float(r[1])); }
    { const auto r = __builtin_amdgcn_permlane32_swap(__float_as_uint(x), __float_as_uint(x), false, false); x = fmaxf(__uint_as_float(r[0]), __uint_as_float(r[1])); }
    return x;
}
__device__ __forceinline__ float max8_dpp(float x) {
    x = fmaxf(x, __builtin_bit_cast(float, __builtin_amdgcn_update_dpp(0, __builtin_bit_cast(int, x), 0xB1, 0xF, 0xF, true)));
    x = fmaxf(x, __builtin_bit_cast(float, __builtin_amdgcn_update_dpp(0, __builtin_bit_cast(int, x), 0x4E, 0xF, 0xF, true)));
    x = fmaxf(x, __builtin_bit_cast(float, __builtin_amdgcn_update_dpp(0, __builtin_bit_cast(int, x), 0x141, 0xF, 0xF, true)));
    return x;
}
__device__ __forceinline__ void p7u_shard(const Params& p, const XTopo tp, unsigned char* smem) {
    unsigned char* ws = p.ws;
    const bf16_t* HB = (const bf16_t*)(ws + OFF_HB); const unsigned short* EX = (const unsigned short*)(ws + OFF_EX); unsigned* ZP = (unsigned*)(ws + OFF_ZP);
    const __amdgpu_buffer_rsrc_t rsU = __builtin_amdgcn_make_buffer_rsrc((void*)(ws + OFF_UT8), 0, 16 << 20, 0x00020000);
    const int tid = tidx(), lane = tid & 63, wid = tid >> 6, k = lane & 7;
    const bool b2 = (lane & 4) != 0, b1 = (lane & 2) != 0, b0 = (lane & 1) != 0;
    const int nwx = (int)tp.nloc * 8, widx = (int)tp.rank * 8 + wid;
    unsigned short* hl = (unsigned short*)(smem + wid * 512);
#define U_LOADP(tt) { const int tc_ = (tt) < T_TOK ? (tt) : T_TOK - 1; const int ln_ = tidx() & 63; \
        ph = ((const unsigned*)HB)[((size_t)tc_ * DM + sl * 128) / 2 + (ln_ & 7) * 8 + (ln_ >> 3)];     \
        pe0 = *(const uint4*)(EX + (size_t)tc_ * 128 + (ln_ >> 3) * 16); pe1 = *(const uint4*)(EX + (size_t)tc_ * 128 + (ln_ >> 3) * 16 + 8); }
#define U_ISSUE(BUF, HQ, SC, slot) { const unsigned ew_[8] = {pe0.x, pe0.y, pe0.z, pe0.w, pe1.x, pe1.y, pe1.z, pe1.w}; \
        _Pragma("unroll") for (int i = 0; i < 16; ++i) { BUF[i] = __builtin_amdgcn_raw_buffer_load_b128(rsU, ROW_VOFF(ew_[i >> 1], i & 1, cbase), 0, 0); } \
        { const float h0_ = __uint_as_float(ph << 16), h1_ = __uint_as_float(ph & 0xffff0000u); \
          const float am_ = wave_max_nolds(fmaxf(fabsf(h0_), fabsf(h1_))); const float inv_ = am_ > 0.f ? 127.0f * __builtin_amdgcn_rcpf(am_) : 0.f; SC = am_ * (1.0f / 127.0f); \
          const unsigned w16_ = __builtin_amdgcn_perm(__float_as_uint(fmaf(h1_, inv_, 12582912.0f)), __float_as_uint(fmaf(h0_, inv_, 12582912.0f)), 0x0c0c0400u); \
          const int ln_ = tidx() & 63; \
          hl[(slot) * 64 + (ln_ & 7) * 8 + (ln_ >> 3)] = (unsigned short)w16_; \
          const uint4 hq4_ = *(const uint4*)(hl + (slot) * 64 + (ln_ & 7) * 8); HQ[0] = hq4_.x; HQ[1] = hq4_.y; HQ[2] = hq4_.z; HQ[3] = hq4_.w; } }
#define U_COMPUTE(BUF, HQ, SC, tt) { int d[16]; \
        _Pragma("unroll") for (int i = 0; i < 16; ++i) { const u32x4v w_ = BUF[i];     \
            d[i] = __builtin_amdgcn_sdot4((int)w_.w, (int)HQ[3], __builtin_amdgcn_sdot4((int)w_.z, (int)HQ[2], __builtin_amdgcn_sdot4((int)w_.y, (int)HQ[1], __builtin_amdgcn_sdot4((int)w_.x, (int)HQ[0], 0, false), false), false), false); } \
        int r8[8], r4[4], r2v[2]; \
        _Pragma("unroll") for (int i = 0; i < 8; ++i) r8[i] = (b2 ? d[8 + i] : d[i]) + DPP_I(DPP_I(b2 ? d[i] : d[8 + i], DPP_HMIR), DPP_QREV); \
        _Pragma("unroll") for (int i = 0; i < 4; ++i) r4[i] = (b1 ? r8[4 + i] : r8[i]) + DPP_I(b1 ? r8[i] : r8[4 + i], DPP_XOR2); \
        _Pragma("unroll") for (int i = 0; i < 2; ++i) r2v[i] = (b0 ? r4[2 + i] : r4[i]) + DPP_I(b0 ? r4[i] : r4[2 + i], DPP_XOR1); \
        if ((tt) < T_TOK) ZP[((size_t)(tt) * 8 + sl) * 64 + (tidx() & 63)] = pack2((float)r2v[0] * SC, (float)r2v[1] * SC); }
#define SBAR __builtin_amdgcn_sched_barrier(0)
    for (int sl = (int)tp.jx; sl < 8; sl += (int)tp.nx) {
        const unsigned cbase = ((unsigned)sl << 21) + (unsigned)(k * 16);
        unsigned ph; uint4 pe0, pe1;
        u32x4v A[16], B[16]; unsigned hqA[4], hqB[4]; float scA, scB;
        int t = widx;
        U_LOADP(t); U_ISSUE(A, hqA, scA, 0); U_LOADP(t + nwx); SBAR;
#pragma unroll 1
        for (; t < T_TOK; t += 2 * nwx) {
            U_ISSUE(B, hqB, scB, 1); SBAR; U_LOADP(t + 2 * nwx); SBAR; U_COMPUTE(A, hqA, scA, t); SBAR;
            U_ISSUE(A, hqA, scA, 0); SBAR; U_LOADP(t + 3 * nwx); SBAR; U_COMPUTE(B, hqB, scB, t + nwx); SBAR;
        }
    }
#undef U_LOADP
#undef U_ISSUE
#undef U_COMPUTE
}
__device__ __forceinline__ void p7w_weights(const Params& p) {
    unsigned char* ws = p.ws;
    const float* GT = (const float*)(ws + OFF_GT); const unsigned* ZP = (const unsigned*)(ws + OFF_ZP); const float* SE = (const float*)(ws + OFF_SE);
    const float* rs2 = (const float*)(ws + OFF_RS2); unsigned short* QA = (unsigned short*)(ws + OFF_QA); float* SA = (float*)(ws + OFF_SA);
    const int lane = tidx() & 63;
    int t = gwave();
    if (t >= T_TOK) return;
    unsigned pz[8]; float2 pgt, pse; float pr2;
#define W_LOAD(tt) { _Pragma("unroll") for (int j = 0; j < 8; ++j) pz[j] = ZP[((size_t)(tt) * 8 + j) * 64 + lane]; \
        pgt = *(const float2*)(GT + (size_t)(tt) * 128 + 2 * lane); pse = *(const float2*)(SE + (size_t)(tt) * 128 + 2 * lane); pr2 = rs2[(tt)]; }
    W_LOAD(t);
    for (; t < T_TOK; t += nwaves()) {
        float z0 = 0.f, z1 = 0.f;
#pragma unroll
        for (int j = 0; j < 8; ++j) { z0 += __uint_as_float(pz[j] << 16); z1 += __uint_as_float(pz[j] & 0xffff0000u); }
        const float s0 = pr2 * pse.x, s1 = pr2 * pse.y, g0 = pgt.x, g1 = pgt.y;
        const int tn = t + nwaves();
        if (tn < T_TOK) W_LOAD(tn);
        const pg8::f32x2 ge = pg8::gelu_pk((pg8::f32x2){z0 * s0, z1 * s1});
        const float a0 = ge.x * g0, a1 = ge.y * g1;
        const float am = wave_max_nolds(fmaxf(fabsf(a0), fabsf(a1))); const float inv = am > 0.f ? 127.0f * __builtin_amdgcn_rcpf(am) : 0.f;
        const unsigned w16 = __builtin_amdgcn_perm(__float_as_uint(fmaf(a1, inv, 12582912.0f)), __float_as_uint(fmaf(a0, inv, 12582912.0f)), 0x0c0c0400u);
        QA[(size_t)t * 64 + lane] = (unsigned short)w16;
        if (lane == 0) SA[t] = am * (1.0f / 127.0f);
    }
#undef W_LOAD
}
#define TR4x4(B0, B1, B2, B3, T0, T1, T2, T3) { \
        const unsigned l01_ = __builtin_amdgcn_perm(B1, B0, 0x05010400u), h01_ = __builtin_amdgcn_perm(B1, B0, 0x07030602u); \
        const unsigned l23_ = __builtin_amdgcn_perm(B3, B2, 0x05010400u), h23_ = __builtin_amdgcn_perm(B3, B2, 0x07030602u); \
        T0 = __builtin_amdgcn_perm(l23_, l01_, 0x05040100u); T1 = __builtin_amdgcn_perm(l23_, l01_, 0x07060302u); \
        T2 = __builtin_amdgcn_perm(h23_, h01_, 0x05040100u); T3 = __builtin_amdgcn_perm(h23_, h01_, 0x07060302u); }
__device__ __forceinline__ void p7v_shard(const Params& p, const XTopo tp) {
    unsigned char* ws = p.ws;
    const unsigned short* EX = (const unsigned short*)(ws + OFF_EX);
    unsigned* Y = (unsigned*)(ws + OFF_Y);
    const unsigned short* QA = (const unsigned short*)(ws + OFF_QA); const float* SA = (const float*)(ws + OFF_SA);
    const __amdgpu_buffer_rsrc_t rsV = __builtin_amdgcn_make_buffer_rsrc((void*)(ws + OFF_VT8), 0, 16 << 20, 0x00020000);
    const int tid = tidx(), lane = tid & 63, wid = tid >> 6, k = lane & 7;
    const bool b5 = (lane & 32) != 0, b4 = (lane & 16) != 0, b3 = (lane & 8) != 0;
    const int nwx = (int)tp.nloc * 8, widx = (int)tp.rank * 8 + wid;
#define V_LOADP(tt) { const int tc_ = (tt) < T_TOK ? (tt) : T_TOK - 1; const int ln_ = tidx() & 63; \
        pe0 = *(const uint4*)(EX + (size_t)tc_ * 128 + (ln_ >> 3) * 16); pe1 = *(const uint4*)(EX + (size_t)tc_ * 128 + (ln_ >> 3) * 16 + 8); \
        pwq = *(const uint4*)(QA + (size_t)tc_ * 64 + (ln_ & ~7)); psa = SA[tc_]; }
#define V_ISSUE(BUF, WQ, SA_, slot) { const unsigned ew_[8] = {pe0.x, pe0.y, pe0.z, pe0.w, pe1.x, pe1.y, pe1.z, pe1.w}; \
        _Pragma("unroll") for (int i = 0; i < 16; ++i) { BUF[i] = __builtin_amdgcn_raw_buffer_load_b128(rsV, ROW_VOFF(ew_[i >> 1], i & 1, cbase), 0, 0); } \
        WQ = pwq; SA_ = psa; }
#define V_COMPUTE(BUF, WQ, SA, tt) { int y[16]; _Pragma("unroll") for (int c = 0; c < 16; ++c) y[c] = 0; \
        const unsigned wq_[4] = {WQ.x, WQ.y, WQ.z, WQ.w}; \
        _Pragma("unroll") for (int jr = 0; jr < 4; ++jr) \
            _Pragma("unroll") for (int j4 = 0; j4 < 4; ++j4) { unsigned t0_, t1_, t2_, t3_; \
                TR4x4(BUF[4 * jr][j4], BUF[4 * jr + 1][j4], BUF[4 * jr + 2][j4], BUF[4 * jr + 3][j4], t0_, t1_, t2_, t3_) \
                y[4 * j4] = __builtin_amdgcn_sdot4((int)t0_, (int)wq_[jr], y[4 * j4], false); y[4 * j4 + 1] = __builtin_amdgcn_sdot4((int)t1_, (int)wq_[jr], y[4 * j4 + 1], false); \
                y[4 * j4 + 2] = __builtin_amdgcn_sdot4((int)t2_, (int)wq_[jr], y[4 * j4 + 2], false); y[4 * j4 + 3] = __builtin_amdgcn_sdot4((int)t3_, (int)wq_[jr], y[4 * j4 + 3], false); } \
        int s8[8], s4[4], s2[2]; \
        _Pragma("unroll") for (int i = 0; i < 8; ++i) { const auto r_ = __builtin_amdgcn_permlane32_swap((unsigned)y[i], (unsigned)y[8 + i], false, false); s8[i] = (int)(r_[0] + r_[1]); } \
        _Pragma("unroll") for (int i = 0; i < 4; ++i) { const auto r_ = __builtin_amdgcn_permlane16_swap((unsigned)s8[i], (unsigned)s8[4 + i], false, false); s4[i] = (int)(r_[0] + r_[1]); } \
        _Pragma("unroll") for (int i = 0; i < 2; ++i) s2[i] = (b3 ? s4[2 + i] : s4[i]) + DPP_I(b3 ? s4[i] : s4[2 + i], DPP_ROR8); \
        if ((tt) < T_TOK) { const int ln_ = tidx() & 63; Y[((size_t)(tt) * DM + sl * 128 + (ln_ & 7) * 16 + (ln_ >> 3) * 2) >> 1] = pack2((float)s2[0] * SA, (float)s2[1] * SA); } }
    for (int sl = (int)tp.jx; sl < 8; sl += (int)tp.nx) {
        const unsigned cbase = ((unsigned)sl << 21) + (unsigned)(k * 16);
        uint4 pe0, pe1, pwq; float psa;
        u32x4v A[16], B[16]; uint4 wqA, wqB; float saA, saB;
        int t = widx;
        V_LOADP(t); V_ISSUE(A, wqA, saA, 0); V_LOADP(t + nwx); SBAR;
#pragma unroll 1
        for (; t < T_TOK; t += 2 * nwx) {
            V_ISSUE(B, wqB, saB, 1); SBAR; V_LOADP(t + 2 * nwx); SBAR; V_COMPUTE(A, wqA, saA, t); SBAR;
            V_ISSUE(A, wqA, saA, 0); SBAR; V_LOADP(t + 3 * nwx); SBAR; V_COMPUTE(B, wqB, saB, t + nwx); SBAR;
        }
    }
#undef V_LOADP
#undef V_ISSUE
#undef V_COMPUTE
#undef SBAR
}
__device__ __forceinline__ void p7f_final(const Params& p) {
    unsigned char* ws = p.ws;
    const unsigned* HB = (const unsigned*)(ws + OFF_HB); const unsigned* Y = (const unsigned*)(ws + OFF_Y);
    const int ln = tidx() & 63;
    int t0 = gwave() * 2;
    if (t0 >= T_TOK) return;
    float4 gq[4];
#pragma unroll
    for (int i = 0; i < 4; ++i) gq[i] = ((const float4*)p.gf)[ln + 64 * i];
    uint2 an[2][4], bn[2][4];
#pragma unroll
    for (int r = 0; r < 2; ++r)
#pragma unroll
        for (int i = 0; i < 4; ++i) { an[r][i] = ((const uint2*)(HB + (size_t)(t0 + r) * (DM / 2)))[ln + 64 * i]; bn[r][i] = ((const uint2*)(Y + (size_t)(t0 + r) * (DM / 2)))[ln + 64 * i]; }
    for (; t0 < T_TOK; t0 += nwaves() * 2) {
        float4 v[2][4];
#pragma unroll
        for (int r = 0; r < 2; ++r)
#pragma unroll
            for (int i = 0; i < 4; ++i) {
                const uint2 a = an[r][i], b = bn[r][i];
                v[r][i].x = __uint_as_float(a.x << 16) + __uint_as_float(b.x << 16); v[r][i].y = __uint_as_float(a.x & 0xffff0000u) + __uint_as_float(b.x & 0xffff0000u);
                v[r][i].z = __uint_as_float(a.y << 16) + __uint_as_float(b.y << 16); v[r][i].w = __uint_as_float(a.y & 0xffff0000u) + __uint_as_float(b.y & 0xffff0000u);
            }
        const int t1 = t0 + nwaves() * 2;
        if (t1 < T_TOK) {
#pragma unroll
            for (int r = 0; r < 2; ++r)
#pragma unroll
                for (int i = 0; i < 4; ++i) { an[r][i] = ((const uint2*)(HB + (size_t)(t1 + r) * (DM / 2)))[ln + 64 * i]; bn[r][i] = ((const uint2*)(Y + (size_t)(t1 + r) * (DM / 2)))[ln + 64 * i]; }
        }
#pragma unroll
        for (int r = 0; r < 2; ++r) {
            float ss = 0.f;
#pragma unroll
            for (int i = 0; i < 4; ++i) ss += v[r][i].x * v[r][i].x + v[r][i].y * v[r][i].y + v[r][i].z * v[r][i].z + v[r][i].w * v[r][i].w;
            const float rs = rsqrtf(wave_sum(ss) * (1.0f / DM) + 1e-6f);
#pragma unroll
            for (int i = 0; i < 4; ++i) {
                float4 o; o.x = v[r][i].x * rs * gq[i].x; o.y = v[r][i].y * rs * gq[i].y; o.z = v[r][i].z * rs * gq[i].z; o.w = v[r][i].w * rs * gq[i].w;
                stnt_f4(p.out + (size_t)(t0 + r) * DM + (ln + 64 * i) * 4, o);
            }
        }
    }
}

__global__ void __launch_bounds__(NTHREADS) mega_kernel(Params p) {
    extern __shared__ __attribute__((aligned(16))) unsigned char smem[];
    float* lds = (float*)smem;
    float* stg = lds + (tidx() >> 6) * STG_FLOATS;
    PG8_LAS unsigned char* ldsp = (PG8_LAS unsigned char*)smem;
    volatile LAS3 unsigned* xst = (volatile LAS3 unsigned*)((LAS3 unsigned char*)smem + pg8::STAGE_BYTES);
    if (threadIdx.x < 8) xst[threadIdx.x] = 0u;
    __syncthreads();
    const XcdBarrier xb = xcd_barrier_post((unsigned*)(p.ws + OFF_BAR), xst);
#define GSYNC() xcd_barrier(xb)
    p0_prep(p, lds); GSYNC();
    p1_g1(p, stg, ldsp); __syncthreads();
    {
        const int G = (int)gridDim.x, nkv = G >= 128 ? 64 : G;
        if ((int)blockIdx.x < nkv) p1_kv(p, ldsp, nkv);
        if (G >= 128) { if ((int)blockIdx.x >= nkv) tab_convert(p, ((int)blockIdx.x - nkv) * 8 + (tidx() >> 6), (G - nkv) * 8); }
        else tab_convert(p, gwave(), nwaves());
    }
    GSYNC();
    p2_pool(p); p2_attn(p, ldsp); __syncthreads(); p3_sgu(p, smem); GSYNC();
    p4(p, ldsp); GSYNC();
    p5(p, ldsp); GSYNC();
    p6(p, ldsp); GSYNC();
    p7a_topk(p, smem); GSYNC();
    { const XTopo tp = xcd_topology(xb, xst); p7u_shard(p, tp, smem); GSYNC(); p7w_weights(p); GSYNC(); p7v_shard(p, tp); GSYNC(); p7f_final(p); }
}

extern "C" void kernel_launch(void* const* d_in, const int* in_sizes, int n_in, void* d_out, int out_size, void* d_ws, size_t ws_size, hipStream_t stream) {
    static int grid_blocks = 0;
    if (!grid_blocks) {
        int dev = 0, cus = 0, per_cu = 0;
        (void)hipGetDevice(&dev);
        (void)hipDeviceGetAttribute(&cus, hipDeviceAttributeMultiprocessorCount, dev);
        if (hipFuncSetAttribute((const void*)mega_kernel, hipFuncAttributeMaxDynamicSharedMemorySize, LDS_BYTES) != hipSuccess) fprintf(stderr, "hipFuncSetAttribute failed\n");
        if (hipOccupancyMaxActiveBlocksPerMultiprocessor(&per_cu, mega_kernel, NTHREADS, LDS_BYTES) != hipSuccess) per_cu = 1;
        (void)hipGetLastError();
        if (per_cu > 1) per_cu = 1;
        if (per_cu < 1) per_cu = 1;
        grid_blocks = cus * per_cu;
    }
    Params p{};
    p.x = (const float*)d_in[0]; p.mem = (const float*)d_in[1]; p.g1 = (const float*)d_in[2]; p.w_in = (const float*)d_in[3];
    p.pool_w = (const float*)d_in[4]; p.pool_scale = (const float*)d_in[5]; p.ln_g = (const float*)d_in[6]; p.ln_b = (const float*)d_in[7];
    p.w_s = (const float*)d_in[8]; p.b_s = (const float*)d_in[9]; p.w_so = (const float*)d_in[10]; p.memg = (const float*)d_in[11];
    p.w_kv = (const float*)d_in[12]; p.w_xo = (const float*)d_in[13]; p.w_out = (const float*)d_in[14]; p.g2 = (const float*)d_in[15];
    p.w_q = (const float*)d_in[16]; p.k1 = (const float*)d_in[17]; p.k2 = (const float*)d_in[18]; p.pu = (const float*)d_in[19];
    p.pv = (const float*)d_in[20]; p.gf = (const float*)d_in[21];
    p.out = (float*)d_out; p.ws = (unsigned char*)d_ws;
    if (hipMemsetAsync((unsigned char*)d_ws + OFF_BAR, 0, 16384, stream) != hipSuccess) fprintf(stderr, "memset of barrier words failed\n");
    void* args[] = {&p};
    hipError_t e = hipLaunchCooperativeKernel((void*)mega_kernel, dim3(grid_blocks), dim3(NTHREADS), args, LDS_BYTES, stream);
    if (e != hipSuccess) fprintf(stderr, "cooperative launch failed: %s (grid %d)\n", hipGetErrorString(e), grid_blocks);
}
```

```cpp
#include <hip/hip_runtime.h>
#include <cstdio>

typedef unsigned short bf16_t;
typedef short bf16x8 __attribute__((ext_vector_type(8)));
typedef float f32x4 __attribute__((ext_vector_type(4)));

#define NTHREADS 512
#define LDS_BYTES (131072 + 256)
constexpr int T_TOK = 32768;
constexpr int SEQ = 4096;
constexpr int DM = 1024;
constexpr size_t MiB = (size_t)1 << 20;

constexpr size_t OFF_GATES = 0;
constexpr size_t OFF_Y     = 0;
constexpr size_t OFF_GU    = 192 * MiB;
constexpr size_t OFF_HB    = 192 * MiB;
constexpr size_t OFF_P     = 256 * MiB;
constexpr size_t OFF_EX    = 256 * MiB;
constexpr size_t OFF_GT    = 264 * MiB;
constexpr size_t OFF_QA    = 296 * MiB;
constexpr size_t OFF_SA    = 300 * MiB;
constexpr size_t OFF_SE    = 280 * MiB;
constexpr size_t OFF_H     = 256 * MiB;
constexpr size_t OFF_GV    = 320 * MiB;
constexpr size_t OFF_UT8   = 160 * MiB;
constexpr size_t OFF_VT8   = 176 * MiB;
constexpr size_t OFF_Q     = 384 * MiB;
constexpr size_t OFF_O     = 384 * MiB;
constexpr size_t OFF_ZP    = 384 * MiB;
constexpr size_t OFF_W     = 448 * MiB;
constexpr size_t OFF_WINT  = OFF_W;
constexpr size_t OFF_WQT   = OFF_WINT + (size_t)7168 * 1024 * 2;
constexpr size_t OFF_WKVT  = OFF_WQT + (size_t)2048 * 1024 * 2;
constexpr size_t OFF_WSOT  = OFF_WKVT + (size_t)2048 * 1024 * 2;
constexpr size_t OFF_WXOT  = OFF_WSOT + (size_t)1024 * 1024 * 2;
constexpr size_t OFF_WOUTT = OFF_WXOT + (size_t)1024 * 1024 * 2;
constexpr size_t OFF_POOLT = OFF_WOUTT + (size_t)1024 * 1024 * 2;
constexpr size_t OFF_WM    = OFF_POOLT + (size_t)4 * 256 * 256 * 2;
constexpr size_t OFF_MEMN  = OFF_WM + (size_t)8 * 128 * 128 * 2;
constexpr size_t OFF_KMAT  = OFF_MEMN + (size_t)2048 * 1024 * 2;
constexpr size_t OFF_VT    = OFF_KMAT + (size_t)2048 * 1024 * 2;
constexpr size_t OFF_RS1   = OFF_VT + (size_t)2048 * 1024 * 2;
constexpr size_t OFF_RS2   = OFF_RS1 + (size_t)T_TOK * 4;
constexpr size_t OFF_KEYB  = OFF_RS2 + (size_t)T_TOK * 4;
constexpr size_t OFF_BAR   = OFF_KEYB + (size_t)2 * 128 * 128 * 2;
constexpr size_t OFF_LSP   = OFF_BAR + 16384;
constexpr size_t OFF_SSQP  = OFF_LSP + (size_t)T_TOK * 64 * 4;
constexpr size_t OFF_WG8   = OFF_SSQP + (size_t)T_TOK * 64 * 4;
constexpr size_t OFF_US    = OFF_WG8 + (size_t)3072 * 1024;
constexpr size_t OFF_VS    = OFF_US + (size_t)16384 * 4;
constexpr size_t OFF_END   = OFF_VS + (size_t)16384 * 4;
static_assert(OFF_END <= 512 * MiB, "workspace overflow");
constexpr size_t OUT_XB = 0, OUT_DIFF = 64 * MiB, OUT_XB8 = 64 * MiB;
constexpr size_t OFF_MERGED = 256 * MiB;
#define WG8_SCALE 64.0f

struct Params {
    const float *x, *mem, *g1, *w_in, *pool_w, *pool_scale, *ln_g, *ln_b, *w_s, *b_s, *w_so, *memg, *w_kv, *w_xo, *w_out, *g2, *w_q, *k1, *k2, *pu, *pv, *gf;
    float* out; unsigned char* ws;
};

__device__ __forceinline__ int tidx() { int t = threadIdx.x; asm volatile("" : "+v"(t)); return t; }
__device__ __forceinline__ bf16_t f2bf(float f) { unsigned u = __float_as_uint(f); u += 0x7FFFu + ((u >> 16) & 1u); return (bf16_t)(u >> 16); }
__device__ __forceinline__ float bf2f(bf16_t b) { return __uint_as_float(((unsigned)b) << 16); }
__device__ __forceinline__ unsigned pack2(float a, float b) { return (unsigned)f2bf(a) | ((unsigned)f2bf(b) << 16); }
__device__ __forceinline__ float gelu_f(float v) { return 0.5f * v * (1.0f + erff(v * 0.70710678118654752f)); }
__device__ __forceinline__ float4 ldnt_f4(const float* p) { const f32x4 v = __builtin_nontemporal_load((const f32x4*)p); return make_float4(v[0], v[1], v[2], v[3]); }
__device__ __forceinline__ void stnt_f4(float* p, float4 o) { __builtin_nontemporal_store((f32x4){o.x, o.y, o.z, o.w}, (f32x4*)p); }
__device__ __forceinline__ float wave_sum(float v) {
#define WS_DPP(x, ctrl) __int_as_float(__builtin_amdgcn_update_dpp(0, __float_as_int(x), (ctrl), 0xF, 0xF, true))
    v += WS_DPP(v, 0xB1); v += WS_DPP(v, 0x4E); v += WS_DPP(v, 0x141); v += WS_DPP(v, 0x128);
#undef WS_DPP
    { const auto r = __builtin_amdgcn_permlane16_swap(__float_as_uint(v), __float_as_uint(v), false, false); v = __uint_as_float(r[0]) + __uint_as_float(r[1]); }
    { const auto r = __builtin_amdgcn_permlane32_swap(__float_as_uint(v), __float_as_uint(v), false, false); v = __uint_as_float(r[0]) + __uint_as_float(r[1]); }
    return v;
}
__device__ __forceinline__ int gwave() { return blockIdx.x * (NTHREADS / 64) + (tidx() >> 6); }
__device__ __forceinline__ int nwaves() { return gridDim.x * (NTHREADS / 64); }

template <int UNR = 2> __device__ __forceinline__ void wave_gemm_64x64(const bf16_t* __restrict__ A, int lda, const bf16_t* __restrict__ Bt, int ldb, int K, f32x4 (&acc)[4][4]) {
    const int lane = tidx() & 63, r = lane & 15, q = lane >> 4;
    const bf16_t* ap = A + (size_t)r * lda + q * 8;
    const bf16_t* bp = Bt + (size_t)r * ldb + q * 8;
    bf16x8 a[4][4], b[4][4];
#define WG_LOAD(st, kk) { _Pragma("unroll") for (int i = 0; i < 4; ++i) { a[st][i] = *(const bf16x8*)(ap + (size_t)i * 16 * lda + (kk)); b[st][i] = *(const bf16x8*)(bp + (size_t)i * 16 * ldb + (kk)); } }
#define WG_MMA(st) { _Pragma("unroll") for (int mi = 0; mi < 4; ++mi) _Pragma("unroll") for (int ni = 0; ni < 4; ++ni) acc[mi][ni] = __builtin_amdgcn_mfma_f32_16x16x32_bf16(a[st][mi], b[st][ni], acc[mi][ni], 0, 0, 0); }
    WG_LOAD(0, 0) WG_LOAD(1, 32) WG_LOAD(2, 64)
#pragma unroll 1
    for (int k = 0; k < K; k += 128) {
        const int k3 = (k + 96 < K) ? k + 96 : 0, k4 = (k + 128 < K) ? k + 128 : 0, k5 = (k + 160 < K) ? k + 160 : 0, k6 = (k + 192 < K) ? k + 192 : 0;
        WG_LOAD(3, k3) __builtin_amdgcn_sched_barrier(0); WG_MMA(0) __builtin_amdgcn_sched_barrier(0);
        WG_LOAD(0, k4) __builtin_amdgcn_sched_barrier(0); WG_MMA(1) __builtin_amdgcn_sched_barrier(0);
        WG_LOAD(1, k5) __builtin_amdgcn_sched_barrier(0); WG_MMA(2) __builtin_amdgcn_sched_barrier(0);
        WG_LOAD(2, k6) __builtin_amdgcn_sched_barrier(0); WG_MMA(3) __builtin_amdgcn_sched_barrier(0);
    }
#undef WG_LOAD
#undef WG_MMA
}
__device__ __forceinline__ void zero_acc(f32x4 (&acc)[4][4]) {
#pragma unroll
    for (int mi = 0; mi < 4; ++mi)
#pragma unroll
        for (int ni = 0; ni < 4; ++ni) acc[mi][ni] = (f32x4){0.f, 0.f, 0.f, 0.f};
}
#define STG_STRIDE 68
#define STG_FLOATS (16 * STG_STRIDE)
template <int N> struct IC { static constexpr int value = N; };
template <int MI, class F> __device__ __forceinline__ void epilogue_step(f32x4 (&acc)[4][4], float* stg, F& f) {
    const int lane = tidx() & 63, q = lane >> 4, r = lane & 15, rr = lane >> 2, cc = (lane & 3) * 16;
#pragma unroll
    for (int ni = 0; ni < 4; ++ni)
#pragma unroll
        for (int j = 0; j < 4; ++j) stg[(4 * q + j) * STG_STRIDE + 16 * ni + r] = acc[MI][ni][j];
    __builtin_amdgcn_wave_barrier(); asm volatile("s_waitcnt lgkmcnt(0)" ::: "memory");
    float v[16];
#pragma unroll
    for (int i = 0; i < 4; ++i) { const float4 t4 = *(const float4*)(stg + rr * STG_STRIDE + cc + 4 * i); v[4 * i] = t4.x; v[4 * i + 1] = t4.y; v[4 * i + 2] = t4.z; v[4 * i + 3] = t4.w; }
    asm volatile("s_waitcnt lgkmcnt(0)" ::: "memory"); __builtin_amdgcn_wave_barrier();
    f(IC<MI>{}, MI * 16 + rr, cc, v);
}
template <class F> __device__ __forceinline__ void epilogue_rows(f32x4 (&acc)[4][4], float* stg, F f) {
    epilogue_step<0>(acc, stg, f); epilogue_step<1>(acc, stg, f); epilogue_step<2>(acc, stg, f); epilogue_step<3>(acc, stg, f);
}
__device__ __forceinline__ void store16_bf16(bf16_t* dst, const float (&v)[16]) {
    uint4 a, b;
    a.x = pack2(v[0], v[1]); a.y = pack2(v[2], v[3]); a.z = pack2(v[4], v[5]); a.w = pack2(v[6], v[7]);
    b.x = pack2(v[8], v[9]); b.y = pack2(v[10], v[11]); b.z = pack2(v[12], v[13]); b.w = pack2(v[14], v[15]);
    *(uint4*)dst = a; *(uint4*)(dst + 8) = b;
}
__device__ __forceinline__ void load16_bf16(const bf16_t* src, float (&v)[16]) {
    const uint4 a = *(const uint4*)src, b = *(const uint4*)(src + 8);
    const unsigned w[8] = {a.x, a.y, a.z, a.w, b.x, b.y, b.z, b.w};
#pragma unroll
    for (int k = 0; k < 8; ++k) { v[2 * k] = __uint_as_float(w[k] << 16); v[2 * k + 1] = __uint_as_float(w[k] & 0xffff0000u); }
}


namespace pg8 {
#define PG8_LAS __attribute__((address_space(3)))
typedef unsigned u32x4 __attribute__((ext_vector_type(4)));
typedef float f32x2 __attribute__((ext_vector_type(2)));
constexpr int BM = 256, BK = 64, HALF = 128, HTB = HALF * BK * 2, STAGE_BYTES = 8 * HTB, NXCD = 8, WGM = 8;
__host__ __device__ __forceinline__ int lds_byte(int r, int c) { const int st = (r >> 4) * 2 + (c >> 5), rr = r & 15, cc = c & 31, ob = rr * 64 + cc * 2; return st * 1024 + (ob ^ (((ob >> 9) & 1) << 5)); }
__host__ __device__ __forceinline__ void stage_rc(int b, int& R, int& C) { const int st = b / 1024, sb = b % 1024, swz = sb ^ (((sb >> 9) & 1) << 5); R = (st >> 1) * 16 + swz / 64; C = (st & 1) * 32 + (swz % 64) / 2; }
__host__ __device__ __forceinline__ int perm32(int rho) { const int n = rho >> 4, i = rho & 15; return 8 * (i >> 2) + 4 * n + (i & 3); }
struct Unit { int pm, pn; };
struct Gemm { const bf16_t* A; const bf16_t* Bt; int lda, ldb, K; size_t a_pm, a_pn, b_pn; size_t b_pm = 0; int b_sh = 0; };
struct StaticOrder {
    int nM, nN, nwg, G, c;
    __device__ void init(int M, int N, int G_, int c_) { nM = M / BM; nN = N / BM; nwg = nM * nN; G = G_; c = c_; }
    __device__ bool next(int i, Unit& u) const {
        const long L = (long)i * G + c; if (L >= nwg) return false;
        int wgid = (int)L; { const int q = nwg / NXCD, r = nwg % NXCD, xcd = wgid % NXCD, off = wgid / NXCD; wgid = (xcd < r ? xcd * (q + 1) : r * (q + 1) + (xcd - r) * q) + off; }
        const int nig = WGM * nN, gid = wgid / nig, fm = gid * WGM, gsz = (nM - fm) < WGM ? (nM - fm) : WGM;
        u.pm = fm + ((wgid % nig) % gsz); u.pn = (wgid % nig) / gsz; return true;
    }
};
typedef __bf16 bf16x2_t __attribute__((ext_vector_type(2)));
__device__ __forceinline__ unsigned cvt_pk_bf16(float lo, float hi) { return __builtin_bit_cast(unsigned, __builtin_convertvector((f32x2){lo, hi}, bf16x2_t)); }
__device__ __forceinline__ f32x2 gelu_pk(f32x2 v) {
    const f32x2 av = __builtin_elementwise_abs(v), d = av * 0.2316418882f + 1.0f;
    f32x2 t; t.x = __builtin_amdgcn_rcpf(d.x); t.y = __builtin_amdgcn_rcpf(d.y);
    f32x2 q = t * 0.5307027145f + (-0.7265760135f); q = q * t + 0.7107068705f; q = q * t + (-0.142248368f); q = q * t + 0.127414796f; q = q * t;
    const f32x2 s = (v * v) * (-0.72134752044f);
    f32x2 e; e.x = __builtin_amdgcn_exp2f(s.x); e.y = __builtin_amdgcn_exp2f(s.y);
    f32x2 mx; mx.x = fmaxf(v.x, 0.f); mx.y = fmaxf(v.y, 0.f);
    return mx - av * (q * e);
}
typedef int i32x8 __attribute__((ext_vector_type(8)));
template <class Epi, class Sched, bool FP8 = false>
__device__ __forceinline__ void gemm_phase(PG8_LAS unsigned char* lds, const Gemm g, const Sched& S, const Epi& E) {
    const int tid = tidx(), wid = __builtin_amdgcn_readfirstlane(tid >> 6), lane = tid & 63, wr = wid >> 2, wc = wid & 3, fr = lane & 15, fq = lane >> 4;
    const int K = g.K, nt = K / BK;
    unsigned voffA[2], voffB[2];
#pragma unroll
    for (int i = 0; i < 2; ++i) { int R, C; stage_rc(tid * 16 + i * 8192, R, C); const int Rb = Epi::PERM ? ((R & ~31) + perm32(R & 31)) : R;
        voffA[i] = (unsigned)(R * g.lda + C) * 2u; voffB[i] = (unsigned)(Rb * g.ldb + C) * 2u; }
    const size_t kstep = (size_t)(BK * 2);
    const size_t hstepA = (size_t)HALF * g.lda * 2, hstepB = (size_t)HALF * g.ldb * 2;
    const unsigned ldsw = (unsigned)wid * 1024u;
    const int aoff = lds_byte(wr * 64 + fr, fq * 8), boff = lds_byte(wc * 32 + fr, fq * 8);
#define PG8_SA(b, h) (((b) * 2 + (h)) * HTB)
#define PG8_SB(b, h) ((4 + (b) * 2 + (h)) * HTB)
#define PG8_STAGE(bufoff, gbase, voff) do { _Pragma("unroll") for (int _i = 0; _i < 2; ++_i) \
        __builtin_amdgcn_global_load_lds((const unsigned*)((const char*)(gbase) + (voff)[_i]), (PG8_LAS unsigned*)(lds + (bufoff) + ldsw + _i * 8192), 16, 0, 0); } while (0)
#define PG8_LDA(dst, b, h) do { _Pragma("unroll") for (int m = 0; m < 4; ++m) _Pragma("unroll") for (int k = 0; k < 2; ++k) dst[m][k] = *(const PG8_LAS bf16x8*)(lds + PG8_SA(b, h) + aoff + m * 2048 + k * 1024); } while (0)
#define PG8_LDB(dst, b, h) do { _Pragma("unroll") for (int n = 0; n < 2; ++n) _Pragma("unroll") for (int k = 0; k < 2; ++k) dst[n][k] = *(const PG8_LAS bf16x8*)(lds + PG8_SB(b, h) + boff + n * 2048 + k * 1024); } while (0)
#define PG8_CAT8(X0, X1) ({ const u32x4 x0_ = __builtin_bit_cast(u32x4, X0), x1_ = __builtin_bit_cast(u32x4, X1); (i32x8){(int)x0_[0], (int)x0_[1], (int)x0_[2], (int)x0_[3], (int)x1_[0], (int)x1_[1], (int)x1_[2], (int)x1_[3]}; })
#define PG8_MMA(ai, bj, At, Bt) do { __builtin_amdgcn_s_setprio(1); _Pragma("unroll") for (int m = 0; m < 4; ++m) _Pragma("unroll") for (int n = 0; n < 2; ++n) { \
        if constexpr (FP8) { const i32x8 a8_ = PG8_CAT8(Bt[n][0], Bt[n][1]), b8_ = PG8_CAT8(At[m][0], At[m][1]); \
            asm volatile("v_mfma_scale_f32_16x16x128_f8f6f4 %0, %1, %2, %0, %3, %3 op_sel_hi:[0,0,0]" : "+v"(acc[ai][bj][m][n]) : "v"(a8_), "v"(b8_), "v"(sc1)); } \
        else { _Pragma("unroll") for (int k = 0; k < 2; ++k) acc[ai][bj][m][n] = __builtin_amdgcn_mfma_f32_16x16x32_bf16(Bt[n][k], At[m][k], acc[ai][bj][m][n], 0, 0, 0); } } \
        __builtin_amdgcn_s_setprio(0); } while (0)
#define PG8_WAIT_V(n) asm volatile("s_waitcnt vmcnt(" #n ")" ::: "memory")
#define PG8_WAIT_L(n) asm volatile("s_waitcnt lgkmcnt(" #n ")" ::: "memory")
#define PG8_BAR __builtin_amdgcn_s_barrier()
#define PG8_SCHED __builtin_amdgcn_sched_barrier(0)
    const int sc1 = 0x7f7f7f7f; (void)sc1;
    Unit cur, nxt; int ui = 0;
    if (!S.next(0, cur)) return;
    f32x4 acc[2][2][4][2];
#pragma unroll
    for (int a = 0; a < 2; ++a)
#pragma unroll
        for (int b = 0; b < 2; ++b)
#pragma unroll
            for (int m = 0; m < 4; ++m)
#pragma unroll
                for (int n = 0; n < 2; ++n) acc[a][b][m][n] = (f32x4){0.f, 0.f, 0.f, 0.f};
    bf16x8 At[4][2], B0[2][2], B1[2][2];
    const char* cA = (const char*)g.A + (size_t)cur.pm * g.a_pm + (size_t)cur.pn * g.a_pn; const char* cB = (const char*)g.Bt + (size_t)cur.pn * g.b_pn + (size_t)(cur.pm >> g.b_sh) * g.b_pm;
    PG8_STAGE(PG8_SB(0, 0), cB, voffB); PG8_STAGE(PG8_SB(0, 1), cB + hstepB, voffB); PG8_STAGE(PG8_SA(0, 0), cA, voffA); PG8_STAGE(PG8_SA(0, 1), cA + hstepA, voffA);
    if (wr == 1) PG8_BAR;
    PG8_WAIT_V(2); PG8_BAR;
    PG8_STAGE(PG8_SB(1, 0), cB + kstep, voffB); PG8_STAGE(PG8_SA(1, 0), cA + kstep, voffA); PG8_STAGE(PG8_SB(1, 1), cB + hstepB + kstep, voffB);
    PG8_WAIT_V(6); PG8_BAR;
    for (;;) {
        const bool has_next = S.next(ui + 1, nxt);
        const char* nA = has_next ? (const char*)g.A + (size_t)nxt.pm * g.a_pm + (size_t)nxt.pn * g.a_pn : cA; const char* nB = has_next ? (const char*)g.Bt + (size_t)nxt.pn * g.b_pn + (size_t)(nxt.pm >> g.b_sh) * g.b_pm : cB;
#pragma unroll 1
        for (int t = 0; t < nt; t += 2) {
            const bool last = (t == nt - 2);
            const char* a1 = cA + (size_t)(t + 1) * kstep;
            const char* a2 = last ? nA : cA + (size_t)(t + 2) * kstep; const char* b2 = last ? nB : cB + (size_t)(t + 2) * kstep;
            const char* a3 = a2 + kstep; const char* b3 = b2 + kstep;
            PG8_LDB(B0, 0, 0); PG8_LDB(B1, 0, 1); PG8_SCHED; PG8_LDA(At, 0, 0); PG8_STAGE(PG8_SA(1, 1), a1 + hstepA, voffA);
            PG8_WAIT_V(8); PG8_WAIT_L(0); PG8_BAR; PG8_MMA(0, 0, At, B0); PG8_MMA(0, 1, At, B1); PG8_BAR; PG8_SCHED;
            PG8_LDA(At, 0, 1); PG8_STAGE(PG8_SB(0, 0), b2, voffB); PG8_STAGE(PG8_SB(0, 1), b2 + hstepB, voffB); PG8_STAGE(PG8_SA(0, 0), a2, voffA);
            PG8_WAIT_V(8); PG8_WAIT_L(0); PG8_BAR; PG8_MMA(1, 0, At, B0); PG8_MMA(1, 1, At, B1); PG8_BAR; PG8_SCHED;
            PG8_LDB(B0, 1, 0); PG8_LDB(B1, 1, 1); PG8_SCHED; PG8_LDA(At, 1, 0); PG8_STAGE(PG8_SA(0, 1), a2 + hstepA, voffA);
            PG8_WAIT_V(8); PG8_WAIT_L(0); PG8_BAR; PG8_MMA(0, 0, At, B0); PG8_MMA(0, 1, At, B1); PG8_BAR; PG8_SCHED;
            PG8_LDA(At, 1, 1); PG8_STAGE(PG8_SB(1, 0), b3, voffB); PG8_STAGE(PG8_SB(1, 1), b3 + hstepB, voffB); PG8_STAGE(PG8_SA(1, 0), a3, voffA);
            PG8_WAIT_V(8); PG8_WAIT_L(0); PG8_BAR; PG8_MMA(1, 0, At, B0); PG8_MMA(1, 1, At, B1); PG8_BAR; PG8_SCHED;
        }
        if (wr == 0) PG8_BAR;
        if constexpr (FP8) asm volatile("s_nop 15\n\ts_nop 15" ::: "memory");
        E(acc, cur, wr, wc, fr, fq);
        if (!has_next) break;
#pragma unroll
        for (int a = 0; a < 2; ++a)
#pragma unroll
            for (int b = 0; b < 2; ++b)
#pragma unroll
                for (int m = 0; m < 4; ++m)
#pragma unroll
                    for (int n = 0; n < 2; ++n) acc[a][b][m][n] = (f32x4){0.f, 0.f, 0.f, 0.f};
        cur = nxt; cA = nA; cB = nB; ++ui;
        if (wr == 1) PG8_BAR;
    }
    PG8_WAIT_V(0);
    PG8_BAR;
#undef PG8_SA
#undef PG8_SB
#undef PG8_STAGE
#undef PG8_LDA
#undef PG8_LDB
#undef PG8_MMA
#undef PG8_CAT8
#undef PG8_WAIT_V
#undef PG8_WAIT_L
#undef PG8_BAR
#undef PG8_SCHED
}
struct EpiPlain {
    static constexpr bool PERM = true;
    bf16_t* out; int ld;
    __device__ __forceinline__ void operator()(const f32x4 (&acc)[2][2][4][2], const Unit& u, int wr, int wc, int fr, int fq) const {
        const int row0 = u.pm * BM + wr * 64 + fr, col0 = u.pn * BM + wc * 32 + 8 * fq;
#pragma unroll
        for (int ai = 0; ai < 2; ++ai)
#pragma unroll
            for (int m = 0; m < 4; ++m) {
                bf16_t* rowp = out + (size_t)(row0 + ai * HALF + m * 16) * ld + col0;
#pragma unroll
                for (int bj = 0; bj < 2; ++bj) {
                    const f32x4 v0 = acc[ai][bj][m][0], v1 = acc[ai][bj][m][1];
                    u32x4 w; w.x = cvt_pk_bf16(v0[0], v0[1]); w.y = cvt_pk_bf16(v0[2], v0[3]); w.z = cvt_pk_bf16(v1[0], v1[1]); w.w = cvt_pk_bf16(v1[2], v1[3]);
                    *(u32x4*)(rowp + bj * HALF) = w;
                }
            }
    }
};
__device__ __forceinline__ unsigned pack_unorm8x4(float a, float b, float c, float d) {
    const unsigned ya = __float_as_uint(a + 12582912.0f), yb = __float_as_uint(b + 12582912.0f);
    const unsigned yc = __float_as_uint(c + 12582912.0f), yd = __float_as_uint(d + 12582912.0f);
    const unsigned t01 = __builtin_amdgcn_perm(yb, ya, 0x00000400u), t23 = __builtin_amdgcn_perm(yd, yc, 0x00000400u);
    return __builtin_amdgcn_perm(t23, t01, 0x05040100u);
}
template <int MODE> struct EpiSeg {
    static constexpr bool PERM = true;
    const float* rs1; bf16_t* out; int ld; float oscale = 1.0f; bf16_t* out2 = nullptr; int nsplit = 1 << 20;
    __device__ __forceinline__ void operator()(const f32x4 (&acc)[2][2][4][2], const Unit& u, int wr, int wc, int fr, int fq) const {
        const bool second = u.pn >= nsplit;
        bf16_t* const ob = second ? out2 : out;
        const int row0 = u.pm * BM + wr * 64 + fr, col0 = (second ? u.pn - nsplit : u.pn) * BM + wc * 32 + 8 * fq;
#pragma unroll
        for (int ai = 0; ai < 2; ++ai)
#pragma unroll
            for (int m = 0; m < 4; ++m) {
                const int row = row0 + ai * HALF + m * 16; const float rs = rs1[row] * oscale;
                bf16_t* rowp = ob + (size_t)row * ld + col0;
#pragma unroll
                for (int bj = 0; bj < 2; ++bj) {
                    f32x4 v0 = acc[ai][bj][m][0] * rs, v1 = acc[ai][bj][m][1] * rs;
                    if (MODE == 1) {
                        const f32x2 a = gelu_pk((f32x2){v0[0], v0[1]}), b = gelu_pk((f32x2){v0[2], v0[3]}), c = gelu_pk((f32x2){v1[0], v1[1]}), d = gelu_pk((f32x2){v1[2], v1[3]});
                        v0 = (f32x4){a.x, a.y, b.x, b.y}; v1 = (f32x4){c.x, c.y, d.x, d.y};
                    } else if (MODE == 2) { v0 = v0 * 0.0625f; v1 = v1 * 0.0625f; }
                    else if (MODE == 3) {
#pragma unroll
                        for (int j = 0; j < 4; ++j) { v0[j] = __builtin_amdgcn_fmed3f(v0[j] * 16.0f, -128.0f, 127.0f) + 128.0f; v1[j] = __builtin_amdgcn_fmed3f(v1[j] * 16.0f, -128.0f, 127.0f) + 128.0f; }
                    }
                    if (MODE == 3) {
                        uint2 w8; w8.x = pack_unorm8x4(v0[0], v0[1], v0[2], v0[3]); w8.y = pack_unorm8x4(v1[0], v1[1], v1[2], v1[3]);
                        *(uint2*)((unsigned char*)ob + (size_t)row * ld + col0 + bj * HALF) = w8;
                    } else {
                    u32x4 w; w.x = cvt_pk_bf16(v0[0], v0[1]); w.y = cvt_pk_bf16(v0[2], v0[3]); w.z = cvt_pk_bf16(v1[0], v1[1]); w.w = cvt_pk_bf16(v1[2], v1[3]);
                    *(u32x4*)(rowp + bj * HALF) = w;
                    }
                }
            }
    }
};
template <int PASS> struct EpiMerged {
    static constexpr bool PERM = true;
    const unsigned char* GATES; bf16_t* MERGED; const float* pool_scale;
    __device__ __forceinline__ void operator()(const f32x4 (&acc)[2][2][4][2], const Unit& u, int wr, int wc, int fr, int fq) const {
        const int row0 = u.pm * BM + wr * 64 + fr, col0 = u.pn * BM + wc * 32 + 8 * fq;
        constexpr int goff = PASS == 0 ? 1024 : (PASS == 1 ? 2048 : 0);
        const unsigned char* gp = GATES + (size_t)row0 * 3072 + goff + col0;
        bf16_t* mp0 = MERGED + (size_t)row0 * 1024 + col0;
        uint2 gw[4][2]; u32x4 old[4][2];
#define EM_LOAD(r)                                                                                              \
    {                                                                                                           \
        const int rr_ = ((r) >> 2) * HALF + ((r) & 3) * 16;                                                     \
        _Pragma("unroll") for (int bj = 0; bj < 2; ++bj) {                                                      \
            gw[(r) & 3][bj] = *(const uint2*)(gp + (size_t)rr_ * 3072 + bj * HALF);                              \
            if (PASS != 0) old[(r) & 3][bj] = *(const u32x4*)(mp0 + (size_t)rr_ * 1024 + bj * HALF);            \
        }                                                                                                       \
    }
        EM_LOAD(0) EM_LOAD(1) EM_LOAD(2) EM_LOAD(3)
        f32x4 ps[2][2];
        if (PASS == 2) {
#pragma unroll
            for (int bj = 0; bj < 2; ++bj) { ps[bj][0] = *(const f32x4*)(pool_scale + col0 + bj * HALF); ps[bj][1] = *(const f32x4*)(pool_scale + col0 + bj * HALF + 4); }
        }
        asm volatile("" ::: "memory");
#pragma unroll
        for (int r = 0; r < 8; ++r) {
            const int ai = r >> 2, m = r & 3;
            u32x4 w[2];
#pragma unroll
            for (int bj = 0; bj < 2; ++bj) {
                float val[8];
#pragma unroll
                for (int j = 0; j < 4; ++j) {
                    const unsigned ga = gw[r & 3][bj].x, gb = gw[r & 3][bj].y;
                    const float ea = __builtin_amdgcn_exp2f(fmaf((float)((ga >> (8 * j)) & 0xffu), -0.09016844005f, 11.5415603264f));
                    const float eb = __builtin_amdgcn_exp2f(fmaf((float)((gb >> (8 * j)) & 0xffu), -0.09016844005f, 11.5415603264f));
                    val[j] = acc[ai][bj][m][0][j] * __builtin_amdgcn_rcpf(1.0f + ea);
                    val[4 + j] = acc[ai][bj][m][1][j] * __builtin_amdgcn_rcpf(1.0f + eb);
                }
                if (PASS == 2) {
#pragma unroll
                    for (int j = 0; j < 4; ++j) { val[j] *= ps[bj][0][j]; val[4 + j] *= ps[bj][1][j]; }
                }
                if (PASS != 0) {
#pragma unroll
                    for (int j = 0; j < 4; ++j) { const unsigned o2 = old[r & 3][bj][j]; val[2 * j] += __uint_as_float(o2 << 16); val[2 * j + 1] += __uint_as_float(o2 & 0xffff0000u); }
                }
                w[bj].x = cvt_pk_bf16(val[0], val[1]); w[bj].y = cvt_pk_bf16(val[2], val[3]); w[bj].z = cvt_pk_bf16(val[4], val[5]); w[bj].w = cvt_pk_bf16(val[6], val[7]);
            }
            if (r + 4 < 8) EM_LOAD(r + 4)
            {
                const int rr = ai * HALF + m * 16;
#pragma unroll
                for (int bj = 0; bj < 2; ++bj) *(u32x4*)(mp0 + (size_t)rr * 1024 + bj * HALF) = w[bj];
            }
            asm volatile("" ::: "memory");
        }
#undef EM_LOAD
    }
};
struct EpiS {
    static constexpr bool PERM = true;
    bf16_t* PM; float* LSP;
    __device__ __forceinline__ void operator()(const f32x4 (&acc)[2][2][4][2], const Unit& u, int wr, int wc, int fr, int fq) const {
        const int row0 = u.pm * BM + wr * 64 + fr, col0 = u.pn * BM + wc * 32 + 8 * fq;
#pragma unroll
        for (int ai = 0; ai < 2; ++ai)
#pragma unroll
            for (int m = 0; m < 4; ++m) {
                const int row = row0 + ai * HALF + m * 16;
                bf16_t* rowp = PM + (size_t)row * 1024 + col0;
                float rsum = 0.f;
#pragma unroll
                for (int bj = 0; bj < 2; ++bj) {
                    f32x4 v0 = acc[ai][bj][m][0], v1 = acc[ai][bj][m][1];
#pragma unroll
                    for (int j = 0; j < 4; ++j) { v0[j] = __expf(fminf(v0[j], 60.f)); v1[j] = __expf(fminf(v1[j], 60.f)); }
                    u32x4 w; w.x = cvt_pk_bf16(v0[0], v0[1]); w.y = cvt_pk_bf16(v0[2], v0[3]); w.z = cvt_pk_bf16(v1[0], v1[1]); w.w = cvt_pk_bf16(v1[2], v1[3]);
                    *(u32x4*)(rowp + bj * HALF) = w;
#pragma unroll
                    for (int j = 0; j < 4; ++j) rsum += __uint_as_float(w[j] << 16) + __uint_as_float(w[j] & 0xffff0000u);
                }
                LSP[((size_t)row * 4 + u.pn) * 16 + wc * 4 + fq] = rsum;
            }
    }
};
struct EpiPV {
    static constexpr bool PERM = true;
    bf16_t* O; const float* LSP;
    __device__ __forceinline__ void operator()(const f32x4 (&acc)[2][2][4][2], const Unit& u, int wr, int wc, int fr, int fq) const {
        const int row0 = u.pm * BM + wr * 64 + fr, col0 = u.pn * BM + wc * 32 + 8 * fq;
        const float* lp0 = LSP + ((size_t)row0 * 4 + u.pn) * 16;
        bf16_t* op0 = O + (size_t)row0 * 1024 + col0;
        f32x4 lq[4][4];
#define PV_LOAD(r)                                                                                              \
    {                                                                                                           \
        const float* lpp_ = lp0 + (size_t)(((r) >> 2) * HALF + ((r) & 3) * 16) * 64;                            \
        _Pragma("unroll") for (int q = 0; q < 4; ++q) lq[(r) & 3][q] = *(const f32x4*)(lpp_ + 4 * q);           \
    }
        PV_LOAD(0) PV_LOAD(1) PV_LOAD(2) PV_LOAD(3)
        asm volatile("" ::: "memory");
#pragma unroll
        for (int r = 0; r < 8; ++r) {
            const int ai = r >> 2, m = r & 3;
            const f32x4 ls = (lq[r & 3][0] + lq[r & 3][1]) + (lq[r & 3][2] + lq[r & 3][3]);
            const float inv = __builtin_amdgcn_rcpf((ls[0] + ls[1]) + (ls[2] + ls[3]));
            u32x4 w[2];
#pragma unroll
            for (int bj = 0; bj < 2; ++bj) {
                const f32x4 v0 = acc[ai][bj][m][0] * inv, v1 = acc[ai][bj][m][1] * inv;
                w[bj].x = cvt_pk_bf16(v0[0], v0[1]); w[bj].y = cvt_pk_bf16(v0[2], v0[3]); w[bj].z = cvt_pk_bf16(v1[0], v1[1]); w[bj].w = cvt_pk_bf16(v1[2], v1[3]);
            }
            if (r + 4 < 8) PV_LOAD(r + 4)
#pragma unroll
            for (int bj = 0; bj < 2; ++bj) *(u32x4*)(op0 + (size_t)(ai * HALF + m * 16) * 1024 + bj * HALF) = w[bj];
            asm volatile("" ::: "memory");
        }
#undef PV_LOAD
    }
};
struct EpiH {
    static constexpr bool PERM = true;
    const bf16_t* xb; bf16_t* HB; float* SSQP;
    __device__ __forceinline__ void operator()(const f32x4 (&acc)[2][2][4][2], const Unit& u, int wr, int wc, int fr, int fq) const {
        const int row0 = u.pm * BM + wr * 64 + fr, col0 = u.pn * BM + wc * 32 + 8 * fq;
        const bf16_t* xp0 = xb + (size_t)row0 * 1024 + col0;
        bf16_t* hp0 = HB + (size_t)row0 * 1024 + col0;
        float* sp0 = SSQP + (size_t)row0 * 64 + u.pn * 16 + wc * 4 + fq;
        u32x4 xv[8][2];
#pragma unroll
        for (int r = 0; r < 8; ++r)
#pragma unroll
            for (int bj = 0; bj < 2; ++bj) xv[r][bj] = *(const u32x4*)(xp0 + (size_t)((r >> 2) * HALF + (r & 3) * 16) * 1024 + bj * HALF);
        asm volatile("" ::: "memory");
#pragma unroll
        for (int r = 0; r < 8; ++r) {
            const int ai = r >> 2, m = r & 3;
            const size_t ro = (size_t)(ai * HALF + m * 16);
            float ss = 0.f;
            u32x4 w[2];
#pragma unroll
            for (int bj = 0; bj < 2; ++bj) {
                const u32x4 xw = xv[r][bj];
                const f32x4 h0 = (f32x4){__uint_as_float(xw[0] << 16), __uint_as_float(xw[0] & 0xffff0000u), __uint_as_float(xw[1] << 16), __uint_as_float(xw[1] & 0xffff0000u)} + acc[ai][bj][m][0];
                const f32x4 h1 = (f32x4){__uint_as_float(xw[2] << 16), __uint_as_float(xw[2] & 0xffff0000u), __uint_as_float(xw[3] << 16), __uint_as_float(xw[3] & 0xffff0000u)} + acc[ai][bj][m][1];
                w[bj].x = cvt_pk_bf16(h0[0], h0[1]); w[bj].y = cvt_pk_bf16(h0[2], h0[3]); w[bj].z = cvt_pk_bf16(h1[0], h1[1]); w[bj].w = cvt_pk_bf16(h1[2], h1[3]);
                ss += (h0[0] * h0[0] + h0[1] * h0[1]) + (h0[2] * h0[2] + h0[3] * h0[3]) + (h1[0] * h1[0] + h1[1] * h1[1]) + (h1[2] * h1[2] + h1[3] * h1[3]);
            }
#pragma unroll
            for (int bj = 0; bj < 2; ++bj) *(u32x4*)(hp0 + ro * 1024 + bj * HALF) = w[bj];
            sp0[ro * 64] = ss;
            asm volatile("" ::: "memory");
        }
    }
};
struct EpiQ2 {
    static constexpr bool PERM = true;
    const float* rs2; bf16_t* Q2;
    __device__ __forceinline__ void operator()(const f32x4 (&acc)[2][2][4][2], const Unit& u, int wr, int wc, int fr, int fq) const {
        const int row0 = u.pm * BM + wr * 64 + fr, col0 = u.pn * BM + wc * 32 + 8 * fq;
#pragma unroll
        for (int ai = 0; ai < 2; ++ai)
#pragma unroll
            for (int m = 0; m < 4; ++m) {
                const int row = row0 + ai * HALF + m * 16; const float rs = rs2[row];
                bf16_t* rowp = Q2 + (size_t)row * 2048 + col0;
#pragma unroll
                for (int bj = 0; bj < 2; ++bj) {
                    const f32x4 v0 = acc[ai][bj][m][0] * rs, v1 = acc[ai][bj][m][1] * rs;
                    u32x4 w; w.x = cvt_pk_bf16(v0[0], v0[1]); w.y = cvt_pk_bf16(v0[2], v0[3]); w.z = cvt_pk_bf16(v1[0], v1[1]); w.w = cvt_pk_bf16(v1[2], v1[3]);
                    *(u32x4*)(rowp + bj * HALF) = w;
                }
            }
    }
};
}

__device__ __forceinline__ void rows_prep(const float* __restrict__ src, int nrows, bf16_t* __restrict__ dst, float* __restrict__ rs_out, const float* __restrict__ gain, bool apply, unsigned* __restrict__ dst8 = nullptr) {
    const int lane = tidx() & 63;
    int t0 = gwave() * 4;
    if (t0 >= nrows) return;
    float4 vn[4][4];
#pragma unroll
    for (int r = 0; r < 4; ++r)
#pragma unroll
        for (int i = 0; i < 4; ++i) vn[r][i] = ldnt_f4(src + (size_t)(t0 + r) * DM + (lane + 64 * i) * 4);
    for (; t0 < nrows; t0 += nwaves() * 4) {
        float4 v[4][4];
#pragma unroll
        for (int r = 0; r < 4; ++r)
#pragma unroll
            for (int i = 0; i < 4; ++i) v[r][i] = vn[r][i];
        const int t1 = t0 + nwaves() * 4;
        if (t1 < nrows) {
#pragma unroll
            for (int r = 0; r < 4; ++r)
#pragma unroll
                for (int i = 0; i < 4; ++i) vn[r][i] = ldnt_f4(src + (size_t)(t1 + r) * DM + (lane + 64 * i) * 4);
        }
#pragma unroll
        for (int r = 0; r < 4; ++r) {
            float ss = 0.f;
#pragma unroll
            for (int i = 0; i < 4; ++i) ss += v[r][i].x * v[r][i].x + v[r][i].y * v[r][i].y + v[r][i].z * v[r][i].z + v[r][i].w * v[r][i].w;
            ss = wave_sum(ss);
            const float rs = rsqrtf(ss * (1.0f / DM) + 1e-6f);
            if (rs_out && lane == 0) rs_out[t0 + r] = rs;
#pragma unroll
            for (int i = 0; i < 4; ++i) {
                float4 o = v[r][i];
                if (apply) { const float4 g = ((const float4*)gain)[lane + 64 * i]; o.x *= rs * g.x; o.y *= rs * g.y; o.z *= rs * g.z; o.w *= rs * g.w; }
                uint2 w; w.x = pack2(o.x, o.y); w.y = pack2(o.z, o.w);
                *(uint2*)(dst + (size_t)(t0 + r) * DM + (lane + 64 * i) * 4) = w;
                if (dst8) { int w8 = 0; w8 = __builtin_amdgcn_cvt_pk_fp8_f32(o.x, o.y, w8, false); w8 = __builtin_amdgcn_cvt_pk_fp8_f32(o.z, o.w, w8, true); dst8[(size_t)(t0 + r) * (DM / 4) + lane + 64 * i] = (unsigned)w8; }
            }
        }
    }
}
struct TItem { const float* W; const float* scale; unsigned char* WT; int ldw, K, k0, n0, fp8; };
__device__ __forceinline__ void titem_load(const TItem& d, int lane, float (&v)[32], float4& s0, float4& s1) {
#pragma unroll
    for (int i = 0; i < 32; ++i) v[i] = __builtin_nontemporal_load(d.W + (size_t)(d.k0 + 2 * i + (lane >> 5)) * d.ldw + d.n0 + (lane & 31));
    s0 = make_float4(1.f, 1.f, 1.f, 1.f); s1 = s0;
    if (d.scale) { s0 = *(const float4*)(d.scale + d.k0 + 8 * (lane & 7)); s1 = *(const float4*)(d.scale + d.k0 + 8 * (lane & 7) + 4); }
}
__device__ __forceinline__ void titem_finish(const TItem& d, float* scr, int lane, const float (&v)[32], float4 s0, float4 s1) {
    const int c = lane & 7;
#pragma unroll
    for (int i = 0; i < 32; ++i) scr[(2 * i + (lane >> 5)) * 33 + (lane & 31)] = v[i];
    __builtin_amdgcn_wave_barrier(); asm volatile("s_waitcnt lgkmcnt(0)" ::: "memory");
    if (d.fp8) {
#pragma unroll
        for (int j = 0; j < 4; ++j) { const int n = (lane >> 3) + 8 * j; const float* sp = scr + (8 * c) * 33 + n;
            int w0 = 0, w1 = 0;
            w0 = __builtin_amdgcn_cvt_pk_fp8_f32(sp[0 * 33] * (s0.x * WG8_SCALE), sp[1 * 33] * (s0.y * WG8_SCALE), w0, false); w0 = __builtin_amdgcn_cvt_pk_fp8_f32(sp[2 * 33] * (s0.z * WG8_SCALE), sp[3 * 33] * (s0.w * WG8_SCALE), w0, true);
            w1 = __builtin_amdgcn_cvt_pk_fp8_f32(sp[4 * 33] * (s1.x * WG8_SCALE), sp[5 * 33] * (s1.y * WG8_SCALE), w1, false); w1 = __builtin_amdgcn_cvt_pk_fp8_f32(sp[6 * 33] * (s1.z * WG8_SCALE), sp[7 * 33] * (s1.w * WG8_SCALE), w1, true);
            uint2 o; o.x = (unsigned)w0; o.y = (unsigned)w1;
            *(uint2*)(d.WT + (size_t)(d.n0 + n) * d.K + d.k0 + 8 * c) = o; }
    } else {
#pragma unroll
        for (int j = 0; j < 4; ++j) { const int n = (lane >> 3) + 8 * j; const float* sp = scr + (8 * c) * 33 + n;
            uint4 o; o.x = pack2(sp[0 * 33] * s0.x, sp[1 * 33] * s0.y); o.y = pack2(sp[2 * 33] * s0.z, sp[3 * 33] * s0.w); o.z = pack2(sp[4 * 33] * s1.x, sp[5 * 33] * s1.y); o.w = pack2(sp[6 * 33] * s1.z, sp[7 * 33] * s1.w);
            *(uint4*)(d.WT + ((size_t)(d.n0 + n) * d.K + d.k0 + 8 * c) * 2) = o; }
    }
    asm volatile("s_waitcnt lgkmcnt(0)" ::: "memory"); __builtin_amdgcn_wave_barrier();
}
__device__ __forceinline__ void p0_prep(const Params& p, float* lds) {
    unsigned char* ws = p.ws;
    rows_prep(p.x, T_TOK, (bf16_t*)((unsigned char*)p.out + OUT_XB), (float*)(ws + OFF_RS1), nullptr, false, (unsigned*)((unsigned char*)p.out + OUT_XB8));
    rows_prep(p.mem, 2048, (bf16_t*)(ws + OFF_MEMN), nullptr, p.memg, true);
    {
        const int lane = tidx() & 63; float* scr = lds + (tidx() >> 6) * (64 * 33);
        constexpr int I_IN = 16 * 128, I_Q = 16 * 64, I_KV = 16 * 64, I_SQ = 16 * 32, I_PL = 4 * 8;
        constexpr int I_G8 = 16 * 96;
        constexpr int NIT = I_G8 + I_IN + I_Q + I_KV + 3 * I_SQ + 4 * I_PL;
        auto mk = [&](const float* W, int ldw, int ncols, const float* scale, unsigned char* WT, int K, int fp8, int item) {
            TItem d; const int nblk = ncols / 32; d.W = W; d.scale = scale; d.WT = WT; d.ldw = ldw; d.K = K; d.k0 = 64 * (item / nblk); d.n0 = 32 * (item % nblk); d.fp8 = fp8; return d; };
        auto decode = [&](int it) {
            int r = it;
            if (r < I_G8) return mk(p.w_in + 4096, 7168, 3072, p.g1, ws + OFF_WG8, 1024, 1, r); r -= I_G8;
            if (r < I_IN) return mk(p.w_in, 7168, 4096, p.g1, ws + OFF_WINT, 1024, 0, r); r -= I_IN;
            if (r < I_Q) return mk(p.w_q, 2048, 2048, p.g2, ws + OFF_WQT, 1024, 0, r); r -= I_Q;
            if (r < I_KV) return mk(p.w_kv, 2048, 2048, nullptr, ws + OFF_WKVT, 1024, 0, r); r -= I_KV;
            if (r < I_SQ) return mk(p.w_so, 1024, 1024, nullptr, ws + OFF_WSOT, 1024, 0, r); r -= I_SQ;
            if (r < I_SQ) return mk(p.w_xo, 1024, 1024, nullptr, ws + OFF_WXOT, 1024, 0, r); r -= I_SQ;
            if (r < I_SQ) return mk(p.w_out, 1024, 1024, nullptr, ws + OFF_WOUTT, 1024, 0, r); r -= I_SQ;
            const int g = r / I_PL; return mk(p.pool_w + (size_t)g * 65536, 256, 256, nullptr, ws + OFF_POOLT + (size_t)g * 65536 * 2, 256, 0, r % I_PL); };
        int it = gwave(); const int nw = nwaves();
        if (it < NIT) {
            TItem dn = decode(it); float vn[32]; float4 sn0, sn1;
            titem_load(dn, lane, vn, sn0, sn1);
            for (; it < NIT; it += nw) {
                const TItem dc = dn; float v[32]; const float4 s0 = sn0, s1 = sn1;
#pragma unroll
                for (int i = 0; i < 32; ++i) v[i] = vn[i];
                if (it + nw < NIT) { dn = decode(it + nw); titem_load(dn, lane, vn, sn0, sn1); }
                titem_finish(dc, scr, lane, v, s0, s1);
            }
        }
    }
    { bf16_t* kb = (bf16_t*)(ws + OFF_KEYB);
      for (int i = blockIdx.x * NTHREADS + tidx(); i < 2 * 128 * 128; i += gridDim.x * NTHREADS) kb[i] = f2bf(i < 16384 ? p.k1[i] : p.k2[i - 16384]); }
    bf16_t* wm = (bf16_t*)(ws + OFF_WM);
    for (int i = blockIdx.x * NTHREADS + tidx(); i < 8 * 128 * 128; i += gridDim.x * NTHREADS) {
        const int t = (i >> 7) & 127, s = i & 127;
        wm[i] = f2bf(s <= t ? p.w_s[i] : 0.f);
    }
}

__device__ __forceinline__ void p1_g1(const Params& p, float* stg, PG8_LAS unsigned char* ldsp) {
    unsigned char* ws = p.ws;
    {
        const bf16_t* XB = (const bf16_t*)((unsigned char*)p.out + OUT_XB); const bf16_t* WinT = (const bf16_t*)(ws + OFF_WINT); const float* rs1 = (const float*)(ws + OFF_RS1);
        const size_t tb = (size_t)256 * 1024 * 2;
        pg8::StaticOrder S1; S1.init(T_TOK, 1024, gridDim.x, blockIdx.x);
        pg8::StaticOrder S3; S3.init(T_TOK, 3072, gridDim.x, blockIdx.x);
        { pg8::Gemm g{XB, WinT, 1024, 1024, 1024, tb, 0, tb}; pg8::EpiSeg<0> E{rs1, (bf16_t*)(ws + OFF_P), 1024}; pg8::gemm_phase(ldsp, g, S1, E); }
        { pg8::StaticOrder S2; S2.init(T_TOK, 2048, gridDim.x, blockIdx.x);
          pg8::Gemm g{XB, WinT + (size_t)1024 * 1024, 1024, 1024, 1024, tb, 0, tb}; pg8::EpiSeg<1> E{rs1, (bf16_t*)(ws + OFF_GU), 1024, 1.0f, (bf16_t*)(ws + OFF_GV), 4}; pg8::gemm_phase(ldsp, g, S2, E); }
        { pg8::Gemm g{XB, WinT + (size_t)3072 * 1024, 1024, 1024, 1024, tb, 0, tb}; pg8::EpiSeg<2> E{rs1, (bf16_t*)(ws + OFF_Q), 1024}; pg8::gemm_phase(ldsp, g, S1, E); }
        {
            pg8::Gemm g{(const bf16_t*)((unsigned char*)p.out + OUT_XB8), (const bf16_t*)(ws + OFF_WG8), 512, 512, 512, (size_t)256 * 1024, 0, (size_t)256 * 1024};
            pg8::EpiSeg<3> E{rs1, (bf16_t*)(ws + OFF_GATES), 3072, 1.0f / WG8_SCALE}; pg8::gemm_phase<pg8::EpiSeg<3>, pg8::StaticOrder, true>(ldsp, g, S3, E); }
    }
}


__device__ __forceinline__ void p1_kv(const Params& p, PG8_LAS unsigned char* ldsp, int nkv) {
    unsigned char* ws = p.ws;
    const bf16_t* MEMN = (const bf16_t*)(ws + OFF_MEMN); const bf16_t* WkvT = (const bf16_t*)(ws + OFF_WKVT);
    const size_t tb = (size_t)256 * 1024 * 2;
    const int half = nkv >> 1, c = blockIdx.x;
    if (nkv < 2 || c < half) {
        pg8::StaticOrder S; S.init(2048, 1024, nkv < 2 ? 1 : half, nkv < 2 ? 0 : c);
        pg8::Gemm g{MEMN, WkvT, 1024, 1024, 1024, tb, 0, tb}; pg8::EpiPlain E{(bf16_t*)(ws + OFF_KMAT), 1024}; pg8::gemm_phase(ldsp, g, S, E);
    }
    if (nkv < 2 || c >= half) {
        pg8::StaticOrder S; S.init(1024, 2048, nkv < 2 ? 1 : nkv - half, nkv < 2 ? 0 : c - half);
        pg8::Gemm g{WkvT + (size_t)1024 * 1024, MEMN, 1024, 1024, 1024, tb, 0, tb}; pg8::EpiPlain E{(bf16_t*)(ws + OFF_VT), 2048}; pg8::gemm_phase(ldsp, g, S, E);
    }
}

typedef short s16x4 __attribute__((ext_vector_type(4)));
__device__ __forceinline__ unsigned offb(unsigned row, unsigned ch) { return 256u * row + 16u * (ch ^ (((row & 3) << 2) | ((row >> 2) & 3))); }
__device__ __forceinline__ unsigned tr_addr16(unsigned lane, unsigned c, unsigned ks, unsigned t) {
    const unsigned g = lane >> 4, q = (lane & 15) >> 2, p = lane & 3;
    return offb(32 * ks + 8 * g + 4 * t + q, 2 * c + (p >> 1)) + 8 * (p & 1);
}
#define SGU_TILE_OFF 0
#define SGU_STAT_OFF 32768
#define SGU_STG_OFF  34816
#define SGU_STG_STRIDE 132
__device__ __forceinline__ void sgu_unit(const Params& p, unsigned char* smem, int bc) {
    unsigned char* ws = p.ws;
    const bf16_t* GV = (const bf16_t*)(ws + OFF_GV); bf16_t* GU = (bf16_t*)(ws + OFF_GU); const bf16_t* WM = (const bf16_t*)(ws + OFF_WM);
    const int tid = tidx(), lane = tid & 63, wid = tid >> 6, r = lane & 15, g = lane >> 4;
    float* stats = (float*)(smem + SGU_STAT_OFF);
    float* stg = (float*)(smem + SGU_STG_OFF) + wid * (16 * SGU_STG_STRIDE);
    const unsigned tile_base = (unsigned)(size_t)(smem + SGU_TILE_OFF);
#pragma unroll 1
    for (int hb = 0; hb < 2; ++hb) {
        uint4 r0[8], r1[8];
#pragma unroll
        for (int i = 0; i < 8; ++i) { const bf16_t* row = GV + ((size_t)bc * 128 + wid * 16 + hb * 8 + i) * DM; r0[i] = *(const uint4*)(row + lane * 8); r1[i] = *(const uint4*)(row + 512 + lane * 8); }
#pragma unroll
        for (int i = 0; i < 8; ++i) {
            const int tok = wid * 16 + hb * 8 + i;
            const unsigned ww[8] = {r0[i].x, r0[i].y, r0[i].z, r0[i].w, r1[i].x, r1[i].y, r1[i].z, r1[i].w};
            float v[16], s1 = 0.f;
#pragma unroll
            for (int k = 0; k < 8; ++k) { v[2 * k] = __uint_as_float(ww[k] << 16); v[2 * k + 1] = __uint_as_float(ww[k] & 0xffff0000u); s1 += v[2 * k] + v[2 * k + 1]; }
            const float mu = wave_sum(s1) * (1.0f / DM);
            float s2 = 0.f;
#pragma unroll
            for (int k = 0; k < 16; ++k) { const float d = v[k] - mu; s2 += d * d; }
            const float rstd = rsqrtf(wave_sum(s2) * (1.0f / DM) + 1e-5f);
            if (lane == 0) { stats[2 * tok] = mu; stats[2 * tok + 1] = rstd; }
        }
    }
    const int ch = tid & 15;
    uint4 gvn[4];
#pragma unroll
    for (int i = 0; i < 4; ++i) gvn[i] = *(const uint4*)(GV + ((size_t)bc * 128 + (tid >> 4) + 32 * i) * DM + ch * 8);
    float4 g0n = *(const float4*)(p.ln_g + ch * 8), g1n = *(const float4*)(p.ln_g + ch * 8 + 4), b0n = *(const float4*)(p.ln_b + ch * 8), b1n = *(const float4*)(p.ln_b + ch * 8 + 4);
    bf16x8 an[4];
#pragma unroll
    for (int ks = 0; ks < 4; ++ks) an[ks] = *(const bf16x8*)(WM + (size_t)(wid * 16 + r) * 128 + ks * 32 + g * 8);
    float bsn[4];
#pragma unroll
    for (int k = 0; k < 4; ++k) bsn[k] = p.b_s[wid * 16 + 4 * k + (lane >> 4)];
    __syncthreads();
#pragma unroll 1
    for (int h = 0; h < 8; ++h) {
        const float4 g0 = g0n, g1 = g1n, b0 = b0n, b1 = b1n;
        bf16x8 a[4];
#pragma unroll
        for (int ks = 0; ks < 4; ++ks) a[ks] = an[ks];
        float bs[4];
#pragma unroll
        for (int k = 0; k < 4; ++k) bs[k] = bsn[k];
        {
            const float gg[8] = {g0.x, g0.y, g0.z, g0.w, g1.x, g1.y, g1.z, g1.w}, bb[8] = {b0.x, b0.y, b0.z, b0.w, b1.x, b1.y, b1.z, b1.w};
#pragma unroll
            for (int i = 0; i < 4; ++i) {
                const int sr = (tid >> 4) + 32 * i;
                const uint4 w = gvn[i];
                const float mu = stats[2 * sr], rstd = stats[2 * sr + 1];
                const unsigned ww[4] = {w.x, w.y, w.z, w.w}; unsigned o[4];
#pragma unroll
                for (int k = 0; k < 4; ++k) {
                    const float x0 = (__uint_as_float(ww[k] << 16) - mu) * rstd * gg[2 * k] + bb[2 * k], x1 = (__uint_as_float(ww[k] & 0xffff0000u) - mu) * rstd * gg[2 * k + 1] + bb[2 * k + 1];
                    o[k] = pack2(x0, x1);
                }
                uint4 ov; ov.x = o[0]; ov.y = o[1]; ov.z = o[2]; ov.w = o[3];
                *(uint4*)(smem + SGU_TILE_OFF + offb(sr, ch)) = ov;
            }
        }
        __syncthreads();
        if (h < 7) {
#pragma unroll
            for (int i = 0; i < 4; ++i) gvn[i] = *(const uint4*)(GV + ((size_t)bc * 128 + (tid >> 4) + 32 * i) * DM + (h + 1) * 128 + ch * 8);
            g0n = *(const float4*)(p.ln_g + (h + 1) * 128 + ch * 8); g1n = *(const float4*)(p.ln_g + (h + 1) * 128 + ch * 8 + 4);
            b0n = *(const float4*)(p.ln_b + (h + 1) * 128 + ch * 8); b1n = *(const float4*)(p.ln_b + (h + 1) * 128 + ch * 8 + 4);
#pragma unroll
            for (int ks = 0; ks < 4; ++ks) an[ks] = *(const bf16x8*)(WM + (size_t)(h + 1) * 16384 + (size_t)(wid * 16 + r) * 128 + ks * 32 + g * 8);
#pragma unroll
            for (int k = 0; k < 4; ++k) bsn[k] = p.b_s[(h + 1) * 128 + wid * 16 + 4 * k + (lane >> 4)];
        }
        const int er = lane >> 4, ec = (lane & 15) * 8;
        bf16_t* gp = GU + ((size_t)bc * 128 + wid * 16 + er) * DM + h * 128 + ec;
        uint4 guk[4];
#pragma unroll
        for (int k = 0; k < 4; ++k) guk[k] = *(const uint4*)(gp + (size_t)(4 * k) * DM);
        f32x4 acc[8];
#pragma unroll
        for (int c = 0; c < 8; ++c) acc[c] = (f32x4){0.f, 0.f, 0.f, 0.f};
#pragma unroll
        for (int c = 0; c < 8; ++c) {
            s16x4 q0, q1, q2, q3, q4, q5, q6, q7;
            asm volatile("ds_read_b64_tr_b16 %0, %8\n\tds_read_b64_tr_b16 %1, %9\n\tds_read_b64_tr_b16 %2, %10\n\tds_read_b64_tr_b16 %3, %11\n\t"
                         "ds_read_b64_tr_b16 %4, %12\n\tds_read_b64_tr_b16 %5, %13\n\tds_read_b64_tr_b16 %6, %14\n\tds_read_b64_tr_b16 %7, %15\n\ts_waitcnt lgkmcnt(0)"
                         : "=&v"(q0), "=&v"(q1), "=&v"(q2), "=&v"(q3), "=&v"(q4), "=&v"(q5), "=&v"(q6), "=&v"(q7)
                         : "v"(tile_base + tr_addr16(lane, c, 0, 0)), "v"(tile_base + tr_addr16(lane, c, 0, 1)), "v"(tile_base + tr_addr16(lane, c, 1, 0)), "v"(tile_base + tr_addr16(lane, c, 1, 1)),
                           "v"(tile_base + tr_addr16(lane, c, 2, 0)), "v"(tile_base + tr_addr16(lane, c, 2, 1)), "v"(tile_base + tr_addr16(lane, c, 3, 0)), "v"(tile_base + tr_addr16(lane, c, 3, 1))
                         : "memory");
            __builtin_amdgcn_sched_barrier(0);
            const bf16x8 b0 = {q0[0], q0[1], q0[2], q0[3], q1[0], q1[1], q1[2], q1[3]}, b1 = {q2[0], q2[1], q2[2], q2[3], q3[0], q3[1], q3[2], q3[3]};
            const bf16x8 b2 = {q4[0], q4[1], q4[2], q4[3], q5[0], q5[1], q5[2], q5[3]}, b3 = {q6[0], q6[1], q6[2], q6[3], q7[0], q7[1], q7[2], q7[3]};
            acc[c] = __builtin_amdgcn_mfma_f32_16x16x32_bf16(a[0], b0, acc[c], 0, 0, 0);
            acc[c] = __builtin_amdgcn_mfma_f32_16x16x32_bf16(a[1], b1, acc[c], 0, 0, 0);
            acc[c] = __builtin_amdgcn_mfma_f32_16x16x32_bf16(a[2], b2, acc[c], 0, 0, 0);
            acc[c] = __builtin_amdgcn_mfma_f32_16x16x32_bf16(a[3], b3, acc[c], 0, 0, 0);
        }
#pragma unroll
        for (int c = 0; c < 8; ++c)
#pragma unroll
            for (int j = 0; j < 4; ++j) stg[(4 * g + j) * SGU_STG_STRIDE + 16 * c + r] = acc[c][j];
        __builtin_amdgcn_wave_barrier(); asm volatile("s_waitcnt lgkmcnt(0)" ::: "memory");
#pragma unroll
        for (int k = 0; k < 4; ++k) {
            const float* sp = stg + (4 * k + er) * SGU_STG_STRIDE + ec;
            const float4 t0 = *(const float4*)sp, t1 = *(const float4*)(sp + 4);
            const float v[8] = {t0.x, t0.y, t0.z, t0.w, t1.x, t1.y, t1.z, t1.w};
            const unsigned gw[4] = {guk[k].x, guk[k].y, guk[k].z, guk[k].w};
            uint4 o; unsigned ow[4];
#pragma unroll
            for (int j = 0; j < 4; ++j) ow[j] = pack2(__uint_as_float(gw[j] << 16) * (v[2 * j] + bs[k]), __uint_as_float(gw[j] & 0xffff0000u) * (v[2 * j + 1] + bs[k]));
            o.x = ow[0]; o.y = ow[1]; o.z = ow[2]; o.w = ow[3];
            *(uint4*)(gp + (size_t)(4 * k) * DM) = o;
        }
        asm volatile("s_waitcnt lgkmcnt(0)" ::: "memory");
        __syncthreads();
    }
}
__device__ __forceinline__ void p3_sgu(const Params& p, unsigned char* smem) {
    for (int bc = blockIdx.x; bc < 256; bc += gridDim.x) sgu_unit(p, smem, bc);
}


template <int WIN> __device__ __forceinline__ void pool_load(const unsigned* __restrict__ P32, int wd, int t0, unsigned (&v)[48]) {
    const int s0 = t0 & (SEQ - 1);
#pragma unroll
    for (int k = 0; k < 16; ++k) v[k] = (k >= 17 - WIN) ? ((s0 - 16 + k >= 0) ? P32[(size_t)(t0 - 16 + k) * 512 + wd] : 0u) : 0u;
#pragma unroll
    for (int k = 0; k < 32; ++k) v[16 + k] = P32[(size_t)(t0 + k) * 512 + wd];
}
template <int WIN> __device__ __forceinline__ void pool_compute(unsigned* __restrict__ D32, int wd, int t0, const unsigned (&v)[48]) {
    const int s0 = t0 & (SEQ - 1);
    float slo = 0.f, shi = 0.f;
#pragma unroll
    for (int k = 17 - WIN; k < 16; ++k) { slo += __uint_as_float(v[k] << 16); shi += __uint_as_float(v[k] & 0xffff0000u); }
#pragma unroll
    for (int i = 0; i < 32; ++i) {
        const float plo = __uint_as_float(v[16 + i] << 16), phi = __uint_as_float(v[16 + i] & 0xffff0000u);
        slo += plo; shi += phi;
        const int sq = s0 + i;
        const float inv = 1.0f / (float)(sq + 1 < WIN ? sq + 1 : WIN);
        D32[(size_t)(t0 + i) * 512 + wd] = pack2(slo * inv - plo, shi * inv - phi);
        slo -= __uint_as_float(v[16 + i - WIN + 1] << 16); shi -= __uint_as_float(v[16 + i - WIN + 1] & 0xffff0000u);
    }
}
template <int WIN> __device__ __forceinline__ void pool_run(const unsigned* __restrict__ P32, unsigned* __restrict__ D32, int item, int stride, int nitems) {
    const int wd = item & 511;
    unsigned vn[48];
    pool_load<WIN>(P32, wd, (item >> 9) * 32, vn);
    for (; item < nitems; item += stride) {
        unsigned v[48];
#pragma unroll
        for (int k = 0; k < 48; ++k) v[k] = vn[k];
        if (item + stride < nitems) pool_load<WIN>(P32, wd, ((item + stride) >> 9) * 32, vn);
        pool_compute<WIN>(D32, wd, (item >> 9) * 32, v);
    }
}
__device__ __forceinline__ void p2_pool(const Params& p) {
    const unsigned* P32 = (const unsigned*)(p.ws + OFF_P); unsigned* D32 = (unsigned*)((unsigned char*)p.out + OUT_DIFF);
    const int item = blockIdx.x * NTHREADS + tidx(), stride = gridDim.x * NTHREADS, nitems = (T_TOK / 32) * 512;
    if (item >= nitems) return;
    const int g = __builtin_amdgcn_readfirstlane((item & 511) >> 7);
    if (g == 0) pool_run<2>(P32, D32, item, stride, nitems); else if (g == 1) pool_run<4>(P32, D32, item, stride, nitems);
    else if (g == 2) pool_run<8>(P32, D32, item, stride, nitems); else pool_run<16>(P32, D32, item, stride, nitems);
}
__device__ __forceinline__ void p2_attn(const Params& p, PG8_LAS unsigned char* ldsp) {
    unsigned char* ws = p.ws;
    bf16_t* QPO = (bf16_t*)(ws + OFF_Q); float* LSP = (float*)(ws + OFF_LSP);
    pg8::StaticOrder S; S.init(T_TOK, 1024, gridDim.x, blockIdx.x);
    {
        pg8::Gemm g{QPO, (const bf16_t*)(ws + OFF_KMAT), 1024, 1024, 256, (size_t)256 * 1024 * 2, (size_t)512, (size_t)512, (size_t)256 * 1024 * 2, 4};
        pg8::EpiS E{QPO, LSP}; pg8::gemm_phase(ldsp, g, S, E);
    }
    asm volatile("s_waitcnt vmcnt(0)" ::: "memory"); __builtin_amdgcn_fence(__ATOMIC_ACQUIRE, "agent"); asm volatile("s_waitcnt vmcnt(0)" ::: "memory"); __syncthreads();
    {
        pg8::Gemm g{QPO, (const bf16_t*)(ws + OFF_VT), 1024, 2048, 256, (size_t)256 * 1024 * 2, (size_t)512, (size_t)256 * 2048 * 2, (size_t)512, 4};
        pg8::EpiPV E{QPO, LSP}; pg8::gemm_phase(ldsp, g, S, E);
    }
}

__device__ __forceinline__ void p4(const Params& p, PG8_LAS unsigned char* ldsp) {
    unsigned char* ws = p.ws;
    const unsigned char* GATES = (const unsigned char*)(ws + OFF_GATES); bf16_t* MERGED = (bf16_t*)(ws + OFF_MERGED);
    pg8::StaticOrder S; S.init(T_TOK, 1024, gridDim.x, blockIdx.x);
    {
        pg8::Gemm g{(const bf16_t*)(ws + OFF_GU), (const bf16_t*)(ws + OFF_WSOT), 1024, 1024, 1024, (size_t)256 * 1024 * 2, 0, (size_t)256 * 1024 * 2};
        pg8::EpiMerged<0> E{GATES, MERGED, p.pool_scale}; pg8::gemm_phase(ldsp, g, S, E);
    }
    {
        pg8::Gemm g{(const bf16_t*)(ws + OFF_O), (const bf16_t*)(ws + OFF_WXOT), 1024, 1024, 1024, (size_t)256 * 1024 * 2, 0, (size_t)256 * 1024 * 2};
        pg8::EpiMerged<1> E{GATES, MERGED, p.pool_scale}; pg8::gemm_phase(ldsp, g, S, E);
    }
    {
        pg8::Gemm g{(const bf16_t*)((unsigned char*)p.out + OUT_DIFF), (const bf16_t*)(ws + OFF_POOLT), 1024, 256, 256, (size_t)256 * 1024 * 2, (size_t)256 * 2, (size_t)256 * 256 * 2};
        pg8::EpiMerged<2> E{GATES, MERGED, p.pool_scale}; pg8::gemm_phase(ldsp, g, S, E);
    }
}
__device__ __forceinline__ void p5(const Params& p, PG8_LAS unsigned char* ldsp) {
    unsigned char* ws = p.ws;
    {
        pg8::Gemm g{(const bf16_t*)(ws + OFF_MERGED), (const bf16_t*)(ws + OFF_WOUTT), 1024, 1024, 1024, (size_t)256 * 1024 * 2, 0, (size_t)256 * 1024 * 2};
        pg8::StaticOrder S; S.init(T_TOK, 1024, gridDim.x, blockIdx.x);
        pg8::EpiH E{(const bf16_t*)((unsigned char*)p.out + OUT_XB), (bf16_t*)(ws + OFF_HB), (float*)(ws + OFF_SSQP)}; pg8::gemm_phase(ldsp, g, S, E);
    }
}
__device__ __forceinline__ void p6(const Params& p, PG8_LAS unsigned char* ldsp) {
    unsigned char* ws = p.ws;
    pg8::Gemm g{(const bf16_t*)(ws + OFF_HB), (const bf16_t*)(ws + OFF_WQT), 1024, 1024, 1024, (size_t)256 * 1024 * 2, 0, (size_t)256 * 1024 * 2};
    pg8::StaticOrder S; S.init(T_TOK, 2048, gridDim.x, blockIdx.x);
    {
        const float* SSQP = (const float*)(ws + OFF_SSQP); float* RS2 = (float*)(ws + OFF_RS2);
        const int tid = tidx();
        pg8::Unit un;
        for (int i = 0; S.next(i, un); ++i)
            if (tid < 256) {
                const int row = un.pm * 256 + tid;
                const f32x4* pp = (const f32x4*)(SSQP + (size_t)row * 64);
                f32x4 a = pp[0];
#pragma unroll
                for (int k = 1; k < 16; ++k) a += pp[k];
                RS2[row] = rsqrtf(((a[0] + a[1]) + (a[2] + a[3])) * (1.0f / DM) + 1e-6f);
            }
        asm volatile("s_waitcnt vmcnt(0)" ::: "memory"); __syncthreads();
    }
    pg8::EpiQ2 E{(const float*)(ws + OFF_RS2), (bf16_t*)(ws + OFF_GATES)}; pg8::gemm_phase(ldsp, g, S, E);
}

#define KMIN ((int)0x80000000)
__device__ __forceinline__ void ce_desc(int& a, int& b) { const int hi = a > b ? a : b, lo = a > b ? b : a; a = hi; b = lo; }
template <int N> __device__ __forceinline__ void bitonic_sort_desc(int (&x)[N]) {
#pragma unroll
    for (int k = 2; k <= N; k <<= 1)
#pragma unroll
        for (int j = k >> 1; j > 0; j >>= 1)
#pragma unroll
            for (int i = 0; i < N; ++i) { const int l = i ^ j; if (l > i) { if ((i & k) == 0) ce_desc(x[i], x[l]); else ce_desc(x[l], x[i]); } }
}
__device__ __forceinline__ void merge_top16(int (&a)[16], const int (&b)[16]) {
#pragma unroll
    for (int i = 0; i < 16; ++i) a[i] = a[i] > b[15 - i] ? a[i] : b[15 - i];
#pragma unroll
    for (int j = 8; j > 0; j >>= 1)
#pragma unroll
        for (int i = 0; i < 16; ++i) { const int l = i ^ j; if (l > i) ce_desc(a[i], a[l]); }
}
__device__ __forceinline__ int enc_f(unsigned u) { return (int)(u ^ ((unsigned)((int)u >> 31) & 0x7fffffffu)); }
__device__ __forceinline__ float sortkey_val(int key, unsigned mask) { return __uint_as_float((unsigned)enc_f((unsigned)key & ~mask)); }
__device__ __forceinline__ int bfi_low(unsigned mask, unsigned lowbits, unsigned x) { unsigned r; asm("v_bfi_b32 %0, %1, %2, %3" : "=v"(r) : "s"(mask), "v"(lowbits), "v"(x)); return (int)r; }
__device__ __forceinline__ int pack7(float score, unsigned idx) { return bfi_low(127u, idx, (unsigned)enc_f(__float_as_uint(score))); }
__device__ __forceinline__ int pack8(float sum, unsigned code) { return bfi_low(255u, code, (unsigned)enc_f(__float_as_uint(sum))); }
__device__ __forceinline__ void sort16_desc(int (&x)[16]) {
    ce_desc(x[0], x[1]); ce_desc(x[2], x[3]); ce_desc(x[0], x[2]); ce_desc(x[1], x[3]); ce_desc(x[1], x[2]); ce_desc(x[4], x[5]); ce_desc(x[6], x[7]); ce_desc(x[4], x[6]); ce_desc(x[5], x[7]); ce_desc(x[5], x[6]); ce_desc(x[0], x[4]); ce_desc(x[2], x[6]); ce_desc(x[2], x[4]); ce_desc(x[1], x[5]); ce_desc(x[3], x[7]); ce_desc(x[3], x[5]); ce_desc(x[1], x[2]); ce_desc(x[3], x[4]); ce_desc(x[5], x[6]); ce_desc(x[8], x[9]); ce_desc(x[10], x[11]); ce_desc(x[8], x[10]); ce_desc(x[9], x[11]); ce_desc(x[9], x[10]); ce_desc(x[12], x[13]); ce_desc(x[14], x[15]); ce_desc(x[12], x[14]); ce_desc(x[13], x[15]); ce_desc(x[13], x[14]); ce_desc(x[8], x[12]); ce_desc(x[10], x[14]); ce_desc(x[10], x[12]); ce_desc(x[9], x[13]); ce_desc(x[11], x[15]); ce_desc(x[11], x[13]); ce_desc(x[9], x[10]); ce_desc(x[11], x[12]); ce_desc(x[13], x[14]); ce_desc(x[0], x[8]); ce_desc(x[4], x[12]); ce_desc(x[4], x[8]); ce_desc(x[2], x[10]); ce_desc(x[6], x[14]); ce_desc(x[6], x[10]); ce_desc(x[2], x[4]); ce_desc(x[6], x[8]); ce_desc(x[10], x[12]); ce_desc(x[1], x[9]); ce_desc(x[5], x[13]); ce_desc(x[5], x[9]); ce_desc(x[3], x[11]); ce_desc(x[7], x[15]); ce_desc(x[7], x[11]); ce_desc(x[3], x[5]); ce_desc(x[7], x[9]); ce_desc(x[11], x[13]); ce_desc(x[1], x[2]); ce_desc(x[3], x[4]); ce_desc(x[5], x[6]); ce_desc(x[7], x[8]); ce_desc(x[9], x[10]); ce_desc(x[11], x[12]); ce_desc(x[13], x[14]);
}
__device__ __forceinline__ void top16_of_32(int (&lo)[16], int (&hi)[16]) { sort16_desc(lo); sort16_desc(hi); merge_top16(lo, hi); }
template <int N> __device__ __forceinline__ void bitonic_merge_desc(int (&c)[N]) {
#pragma unroll
    for (int j = N >> 1; j > 0; j >>= 1)
#pragma unroll
        for (int i = 0; i < N; ++i) { const int l = i ^ j; if (l > i) ce_desc(c[i], c[l]); }
}
#define PK2(a, b) pack8(v1[a] + v2[b], 255u - (unsigned)((a) * 16 + (b)))
__device__ __forceinline__ void peer_level2(const int (&L1)[16], const int (&L2)[16], int (&w)[16]) {
    float v1[16], v2[16];
#pragma unroll
    for (int i = 0; i < 16; ++i) { v1[i] = sortkey_val(L1[i], 127u); v2[i] = sortkey_val(L2[i], 127u); }
    int T[16], C0[16];
#pragma unroll
    for (int i = 0; i < 16; ++i) T[i] = PK2(0, i);
#pragma unroll
    for (int i = 0; i < 15; ++i) C0[i] = PK2(i + 1, 0);
    C0[15] = KMIN;
    merge_top16(T, C0);
    int Y[8] = {PK2(2, 1), PK2(2, 2), PK2(2, 3), PK2(2, 4), KMIN, PK2(3, 3), PK2(3, 2), PK2(3, 1)};
    bitonic_merge_desc<8>(Y);
    int A[16] = {PK2(1, 1), PK2(1, 2), PK2(1, 3), PK2(1, 4), PK2(1, 5), PK2(1, 6), PK2(1, 7), KMIN, Y[7], Y[6], Y[5], Y[4], Y[3], Y[2], Y[1], Y[0]};
    bitonic_merge_desc<16>(A);
    merge_top16(T, A);
    int B[8] = {PK2(4, 1), PK2(4, 2), KMIN, KMIN, KMIN, PK2(7, 1), PK2(6, 1), PK2(5, 1)};
    bitonic_merge_desc<8>(B);
#pragma unroll
    for (int i = 8; i < 16; ++i) T[i] = T[i] > B[15 - i] ? T[i] : B[15 - i];
    bitonic_merge_desc<16>(T);
#pragma unroll
    for (int i = 0; i < 16; ++i) w[i] = T[i];
}
#undef PK2


__device__ __forceinline__ float wave_max(float v) {
#pragma unroll
    for (int o = 32; o > 0; o >>= 1) v = fmaxf(v, __shfl_xor(v, o, 64));
    return v;
}
__device__ __forceinline__ unsigned pack_i8x4(float a, float b, float c, float d, float inv) {
    const unsigned ya = __float_as_uint(fmaf(a, inv, 12582912.0f)), yb = __float_as_uint(fmaf(b, inv, 12582912.0f));
    const unsigned yc = __float_as_uint(fmaf(c, inv, 12582912.0f)), yd = __float_as_uint(fmaf(d, inv, 12582912.0f));
    const unsigned t01 = __builtin_amdgcn_perm(yb, ya, 0x00000400u), t23 = __builtin_amdgcn_perm(yd, yc, 0x00000400u);
    return __builtin_amdgcn_perm(t23, t01, 0x05040100u);
}
__device__ __forceinline__ void tabrow_load(const float* __restrict__ tab, int e, int lane, float4 (&a)[4]) {
#pragma unroll
    for (int i = 0; i < 4; ++i) a[i] = ldnt_f4(tab + (size_t)e * 1024 + 4 * lane + 256 * i);
}
__device__ __forceinline__ void tabrow_store(const float* __restrict__ gain, unsigned char* __restrict__ dst, float* __restrict__ scl, int e, int lane, float4 (&a)[4]) {
    float am = 0.f;
#pragma unroll
    for (int i = 0; i < 4; ++i) { if (gain) { const float4 g = *(const float4*)(gain + 4 * lane + 256 * i); a[i].x *= g.x; a[i].y *= g.y; a[i].z *= g.z; a[i].w *= g.w; }
        am = fmaxf(am, fmaxf(fmaxf(fabsf(a[i].x), fabsf(a[i].y)), fmaxf(fabsf(a[i].z), fabsf(a[i].w)))); }
    am = wave_max(am);
    const float inv = am > 0.f ? 127.0f / am : 0.f;
#pragma unroll
    for (int i = 0; i < 4; ++i)
        *(unsigned*)(dst + ((size_t)(2 * i + (lane >> 5)) << 21) + ((size_t)e << 7) + ((4 * lane) & 127)) = pack_i8x4(a[i].x, a[i].y, a[i].z, a[i].w, inv);
    if (lane == 0) scl[e] = am * (1.0f / 127.0f);
}
__device__ __forceinline__ void tab_convert(const Params& p, int wave0, int nw) {
    const int lane = tidx() & 63;
    int e = wave0; float4 un[4];
    if (e < 32768) tabrow_load(e < 16384 ? p.pu : p.pv, e & 16383, lane, un);
    for (; e < 32768; e += nw) {
        float4 uc[4];
#pragma unroll
        for (int i = 0; i < 4; ++i) uc[i] = un[i];
        const int en = e + nw;
        if (en < 32768) tabrow_load(en < 16384 ? p.pu : p.pv, en & 16383, lane, un);
        if (e < 16384) tabrow_store(p.g2, p.ws + OFF_UT8, (float*)(p.ws + OFF_US), e, lane, uc);
        else tabrow_store(nullptr, p.ws + OFF_VT8, (float*)(p.ws + OFF_VS), e - 16384, lane, uc);
    }
}
__device__ __forceinline__ void p7a_topk(const Params& p, unsigned char* smem) {
    unsigned char* ws = p.ws;
    const bf16_t* Q2 = (const bf16_t*)(ws + OFF_GATES); const bf16_t* KEYB = (const bf16_t*)(ws + OFF_KEYB);
    unsigned short* EX = (unsigned short*)(ws + OFF_EX); float* GT = (float*)(ws + OFF_GT); float* SE = (float*)(ws + OFF_SE); const float* US = (const float*)(ws + OFF_US); const float* VS = (const float*)(ws + OFF_VS);
    const int tid = tidx(), lane = tid & 63, wid = tid >> 6, q = lane >> 4, r = lane & 15;
#pragma unroll
    for (int i = 0; i < 8; ++i) {
        const int id = tid + NTHREADS * i, half = id >> 11, key = (id >> 4) & 127, c = id & 15;
        *(uint4*)(smem + half * 32768 + key * 256 + ((c ^ (key & 15)) << 4)) = *(const uint4*)(KEYB + (size_t)id * 8);
    }
    __syncthreads();
    unsigned char* idxs = smem + 65536 + wid * 2048 + lane * 32;
    bf16x8 bqn[2][4];
    {
        const int g0 = gwave() < T_TOK / 16 ? gwave() : 0;
#pragma unroll
        for (int half = 0; half < 2; ++half)
#pragma unroll
            for (int ks = 0; ks < 4; ++ks) bqn[half][ks] = *(const bf16x8*)(Q2 + (size_t)(g0 * 16 + r) * 2048 + half * 128 + ks * 32 + q * 8);
    }
    for (int grp = gwave(); grp < T_TOK / 16; grp += nwaves()) {
        const int t0 = grp * 16;
#pragma unroll 1
        for (int hh = 0; hh < 2; ++hh) {
            int Lk[2][16];
#pragma unroll
            for (int i = 0; i < 16; ++i) { Lk[0][i] = KMIN; Lk[1][i] = KMIN; }
#pragma unroll 1
            for (int j = 0; j < 4; ++j) {
                const int h = 4 * hh + j;
                bf16x8 bq[2][4];
#pragma unroll
                for (int half = 0; half < 2; ++half)
#pragma unroll
                    for (int ks = 0; ks < 4; ++ks) bq[half][ks] = bqn[half][ks];
                {
                    const int hn = (h + 1) & 7; int gn = (h == 7) ? grp + nwaves() : grp; if (gn >= T_TOK / 16) gn = grp;
                    const int rq = tidx() & 15, qq = (tidx() & 63) >> 4;
#pragma unroll
                    for (int half = 0; half < 2; ++half)
#pragma unroll
                        for (int ks = 0; ks < 4; ++ks) bqn[half][ks] = *(const bf16x8*)(Q2 + (size_t)(gn * 16 + rq) * 2048 + hn * 256 + half * 128 + ks * 32 + qq * 8);
                }
                const bool mine = ((tidx() & 63) >> 4) == j;
#pragma unroll
                for (int half = 0; half < 2; ++half) {
                    f32x4 acc[8];
                    bf16x8 kf[2][8];
#define P7A_KLOAD(buf, nb0) { _Pragma("unroll") for (int n2 = 0; n2 < 2; ++n2) _Pragma("unroll") for (int ks = 0; ks < 4; ++ks) \
        kf[buf][n2 * 4 + ks] = *(const bf16x8*)(smem + half * 32768 + (16 * ((nb0) + n2) + r) * 256 + (((4 * ks + q) ^ r) << 4)); }
                    P7A_KLOAD(0, 0);
#pragma unroll
                    for (int nbp = 0; nbp < 4; ++nbp) {
                        if (nbp < 3) { P7A_KLOAD((nbp + 1) & 1, 2 * (nbp + 1)); }
                        __builtin_amdgcn_sched_barrier(0);
#pragma unroll
                        for (int n2 = 0; n2 < 2; ++n2) {
                            const int nb = 2 * nbp + n2;
                            acc[nb] = (f32x4){0.f, 0.f, 0.f, 0.f};
#pragma unroll
                            for (int ks = 0; ks < 4; ++ks) acc[nb] = __builtin_amdgcn_mfma_f32_16x16x32_bf16(kf[nbp & 1][n2 * 4 + ks], bq[half][ks], acc[nb], 0, 0, 0);
                        }
                        __builtin_amdgcn_sched_barrier(0);
                    }
#undef P7A_KLOAD
                    int lo[16], hi[16], o[16];
#pragma unroll
                    for (int nb = 0; nb < 4; ++nb)
#pragma unroll
                        for (int jj = 0; jj < 4; ++jj) { lo[nb * 4 + jj] = pack7(acc[nb][jj], 16 * nb + 4 * q + jj); hi[nb * 4 + jj] = pack7(acc[nb + 4][jj], 16 * (nb + 4) + 4 * q + jj); }
                    top16_of_32(lo, hi);
#pragma unroll
                    for (int i = 0; i < 16; ++i) o[i] = __shfl_xor(lo[i], 16, 64);
                    merge_top16(lo, o);
#pragma unroll
                    for (int i = 0; i < 16; ++i) o[i] = __shfl_xor(lo[i], 32, 64);
                    merge_top16(lo, o);
#pragma unroll
                    for (int i = 0; i < 16; ++i) Lk[half][i] = mine ? lo[i] : Lk[half][i];
                }
            }
            const int hq = 4 * hh + q;
            int w[16]; peer_level2(Lk[0], Lk[1], w);
#pragma unroll
            for (int i4 = 0; i4 < 4; ++i4) {
                ((unsigned*)idxs)[i4] = ((unsigned)Lk[0][4 * i4] & 127u) | (((unsigned)Lk[0][4 * i4 + 1] & 127u) << 8) | (((unsigned)Lk[0][4 * i4 + 2] & 127u) << 16) | (((unsigned)Lk[0][4 * i4 + 3] & 127u) << 24);
                ((unsigned*)idxs)[4 + i4] = ((unsigned)Lk[1][4 * i4] & 127u) | (((unsigned)Lk[1][4 * i4 + 1] & 127u) << 8) | (((unsigned)Lk[1][4 * i4 + 2] & 127u) << 16) | (((unsigned)Lk[1][4 * i4 + 3] & 127u) << 24);
            }
            const float mx = sortkey_val(w[0], 255u);
            float ev[16], den = 0.f; unsigned ex[16];
#pragma unroll
            for (int k = 0; k < 16; ++k) {
                ev[k] = __expf(sortkey_val(w[k], 255u) - mx); den += ev[k];
                const unsigned code = 255u - ((unsigned)w[k] & 255u);
                ex[k] = (unsigned)idxs[code >> 4] * 128u + (unsigned)idxs[16 + (code & 15u)];
            }
            const float inv = 1.0f / den;
            float su[16], sv[16];
#pragma unroll
            for (int k = 0; k < 16; ++k) { su[k] = US[ex[k]]; sv[k] = VS[ex[k]] * (ev[k] * inv); }
            const size_t ob = (size_t)(t0 + r) * 128 + hq * 16;
            uint4 e0, e1;
            e0.x = ex[0] | (ex[1] << 16); e0.y = ex[2] | (ex[3] << 16); e0.z = ex[4] | (ex[5] << 16); e0.w = ex[6] | (ex[7] << 16);
            e1.x = ex[8] | (ex[9] << 16); e1.y = ex[10] | (ex[11] << 16); e1.z = ex[12] | (ex[13] << 16); e1.w = ex[14] | (ex[15] << 16);
            *(uint4*)(EX + ob) = e0; *(uint4*)(EX + ob + 8) = e1;
#pragma unroll
            for (int c = 0; c < 4; ++c) {
                *(float4*)(SE + ob + 4 * c) = make_float4(su[4 * c], su[4 * c + 1], su[4 * c + 2], su[4 * c + 3]);
                *(float4*)(GT + ob + 4 * c) = make_float4(sv[4 * c], sv[4 * c + 1], sv[4 * c + 2], sv[4 * c + 3]);
            }
        }
    }
}


#define XB_TMO      128
#define XB_XCNT(j)  (256  + 64 * (j))
#define XB_XSUB(j)  (1280 + 64 * (j))
#define XB_XGEN(j)  (2304 + 64 * (j))
#define XB_TOP      3328
#define XB_TOPGEN   3392
#define XCD_BAR_WORDS 3456
#define XB_SPIN_CAP (1u << 20)
#define LAS3 __attribute__((address_space(3)))
__device__ __forceinline__ unsigned xb_ld(unsigned* p)              { return __hip_atomic_load(p, __ATOMIC_RELAXED, __HIP_MEMORY_SCOPE_AGENT); }
__device__ __forceinline__ unsigned xb_add(unsigned* p, unsigned v) { return __hip_atomic_fetch_add(p, v, __ATOMIC_RELAXED, __HIP_MEMORY_SCOPE_AGENT); }
__device__ __forceinline__ unsigned xb_xcc_id() { return (unsigned)__builtin_amdgcn_s_getreg((3 << 11) | 20) & 0xFu; }
#define XB_SPIN(cond, bar) do { unsigned _sp = 0; while (cond) { __builtin_amdgcn_s_sleep(1); \
    if ((++_sp & 255u) == 0u) { if (xb_ld(&(bar)[XB_TMO])) break; if (_sp > XB_SPIN_CAP) { atomicAdd(&(bar)[XB_TMO], 1u); break; } } } } while (0)
struct XcdBarrier { unsigned* bar; unsigned x; volatile LAS3 unsigned* st; };
__device__ __forceinline__ XcdBarrier xcd_barrier_post(unsigned* bar, volatile LAS3 unsigned* st) {
    XcdBarrier b; b.bar = bar; b.x = xb_xcc_id(); b.st = st;
    if (threadIdx.x == 0) st[2] = xb_add(&bar[XB_XCNT(b.x)], 1u);
    return b;
}
__device__ __forceinline__ void xcd_barrier_complete(unsigned* bar, unsigned x, unsigned& nloc, unsigned& nx) {
    const unsigned G = gridDim.x * gridDim.y * gridDim.z;
    unsigned sum, cnt, mine, sp = 0u;
    for (;;) {
        sum = 0u; cnt = 0u; mine = 0u;
#pragma unroll
        for (unsigned j = 0; j < 16; ++j) { const unsigned c = xb_ld(&bar[XB_XCNT(j)]); sum += c; cnt += (c > 0u) ? 1u : 0u; mine = (j == x) ? c : mine; }
        if (sum == G) break;
        __builtin_amdgcn_s_sleep(1);
        if ((++sp & 255u) == 0u) { if (xb_ld(&bar[XB_TMO])) break; if (sp > XB_SPIN_CAP) { atomicAdd(&bar[XB_TMO], 1u); break; } }
    }
    nloc = mine > 0u ? mine : 1u; nx = cnt > 0u ? cnt : 1u;
}
__device__ __forceinline__ void xcd_barrier(const XcdBarrier& b) {
    asm volatile("s_waitcnt vmcnt(0)" ::: "memory");
    __syncthreads();
    if (threadIdx.x == 0) {
        unsigned* bar = b.bar;
        __builtin_amdgcn_s_waitcnt(0);
        unsigned nloc = b.st[0], nx = b.st[1];
        if (nloc == 0u) { xcd_barrier_complete(bar, b.x, nloc, nx); b.st[0] = nloc; b.st[1] = nx; }
        const unsigned old = xb_add(&bar[XB_XSUB(b.x)], 1u);
        const unsigned gen = old / nloc;
        if (old + 1u == (gen + 1u) * nloc) {
            __builtin_amdgcn_fence(__ATOMIC_RELEASE, "agent");
            asm volatile("s_waitcnt vmcnt(0)" ::: "memory");
            const unsigned og = xb_add(&bar[XB_TOP], 1u);
            const unsigned tg = og / nx;
            if (og + 1u == (tg + 1u) * nx) xb_add(&bar[XB_TOPGEN], 1u);
            else XB_SPIN(xb_ld(&bar[XB_TOPGEN]) == tg, bar);
            __builtin_amdgcn_fence(__ATOMIC_ACQUIRE, "agent");
            xb_add(&bar[XB_XGEN(b.x)], 1u);
            asm volatile("s_waitcnt vmcnt(0)" ::: "memory");
        } else {
            XB_SPIN(xb_ld(&bar[XB_XGEN(b.x)]) == gen, bar);
            __builtin_amdgcn_fence(__ATOMIC_ACQUIRE, "agent");
            asm volatile("s_waitcnt vmcnt(0)" ::: "memory");
        }
    }
    __syncthreads();
}


typedef float f32x2v __attribute__((ext_vector_type(2)));
typedef unsigned u32x4v __attribute__((ext_vector_type(4)));
struct XTopo { unsigned nloc, nx, rank, jx; };
__device__ __forceinline__ XTopo xcd_topology(const XcdBarrier& xb, volatile LAS3 unsigned* xst) {
    if (threadIdx.x == 0) { unsigned jx = 0;
#pragma unroll
        for (unsigned j = 0; j < 16; ++j) { const unsigned c = xb_ld(&xb.bar[XB_XCNT(j)]); jx += (j < xb.x && c > 0u) ? 1u : 0u; }
        xst[3] = jx; }
    __syncthreads();
    XTopo t; t.nloc = xst[0]; t.nx = xst[1]; t.rank = xst[2]; t.jx = xst[3];
    __syncthreads();
    return t;
}
#define SHARD_CVT(W_) const f32x2v c0_ = __builtin_amdgcn_cvt_pk_f32_fp8((int)(W_).x, false), c1_ = __builtin_amdgcn_cvt_pk_f32_fp8((int)(W_).x, true), c2_ = __builtin_amdgcn_cvt_pk_f32_fp8((int)(W_).y, false), c3_ = __builtin_amdgcn_cvt_pk_f32_fp8((int)(W_).y, true), \
        c4_ = __builtin_amdgcn_cvt_pk_f32_fp8((int)(W_).z, false), c5_ = __builtin_amdgcn_cvt_pk_f32_fp8((int)(W_).z, true), c6_ = __builtin_amdgcn_cvt_pk_f32_fp8((int)(W_).w, false), c7_ = __builtin_amdgcn_cvt_pk_f32_fp8((int)(W_).w, true);
__device__ __forceinline__ unsigned row_voff(unsigned w, int hi, unsigned cbase) {
    unsigned r;
    if (hi) asm("v_mad_u32_u16 %0, %1, %2, %3 op_sel:[1,0,0,0]" : "=v"(r) : "v"(w), "s"(128u), "v"(cbase));
    else asm("v_mad_u32_u16 %0, %1, %2, %3" : "=v"(r) : "v"(w), "s"(128u), "v"(cbase));
    return r;
}
#define ROW_VOFF(w, hi, cb) row_voff((w), (hi), (cb))
#define DPP_I(v, ctrl) __builtin_amdgcn_update_dpp(0, (int)(v), (ctrl), 0xF, 0xF, true)
#define DPP_XOR1 0xB1
#define DPP_XOR2 0x4E
#define DPP_HMIR 0x141
#define DPP_QREV 0x1B
#define DPP_ROR8 0x128
__device__ __forceinline__ float wave_max_nolds(float x) {
    x = fmaxf(x, __int_as_float(DPP_I(__float_as_int(x), DPP_XOR1))); x = fmaxf(x, __int_as_float(DPP_I(__float_as_int(x), DPP_XOR2)));
    x = fmaxf(x, __int_as_float(DPP_I(__float_as_int(x), DPP_HMIR))); x = fmaxf(x, __int_as_float(DPP_I(__float_as_int(x), DPP_ROR8)));
    { const auto r = __builtin_amdgcn_permlane16_swap(__float_as_uint(x), __float_as_uint(x), false, false); x = fmaxf(__uint_as_float(r[0]), __uint_as_float(r[1])); }
    { const auto r = __builtin_amdgcn_permlane32_swap(__float_as_uint(x), __float_as_uint(x), false, false); x = fmaxf(__uint_as_float(r[0]), __uint_as_float(r[1])); }
    return x;
}
__device__ __forceinline__ float max8_dpp(float x) {
    x = fmaxf(x, __builtin_bit_cast(float, __builtin_amdgcn_update_dpp(0, __builtin_bit_cast(int, x), 0xB1, 0xF, 0xF, true)));
    x = fmaxf(x, __builtin_bit_cast(float, __builtin_amdgcn_update_dpp(0, __builtin_bit_cast(int, x), 0x4E, 0xF, 0xF, true)));
    x = fmaxf(x, __builtin_bit_cast(float, __builtin_amdgcn_update_dpp(0, __builtin_bit_cast(int, x), 0x141, 0xF, 0xF, true)));
    return x;
}
__device__ __forceinline__ void p7u_shard(const Params& p, const XTopo tp, unsigned char* smem) {
    unsigned char* ws = p.ws;
    const bf16_t* HB = (const bf16_t*)(ws + OFF_HB); const unsigned short* EX = (const unsigned short*)(ws + OFF_EX); unsigned* ZP = (unsigned*)(ws + OFF_ZP);
    const __amdgpu_buffer_rsrc_t rsU = __builtin_amdgcn_make_buffer_rsrc((void*)(ws + OFF_UT8), 0, 16 << 20, 0x00020000);
    const int tid = tidx(), lane = tid & 63, wid = tid >> 6, k = lane & 7;
    const bool b2 = (lane & 4) != 0, b1 = (lane & 2) != 0, b0 = (lane & 1) != 0;
    const int nwx = (int)tp.nloc * 8, widx = (int)tp.rank * 8 + wid;
    unsigned short* hl = (unsigned short*)(smem + wid * 512);
#define U_LOADP(tt) { const int tc_ = (tt) < T_TOK ? (tt) : T_TOK - 1; const int ln_ = tidx() & 63; \
        ph = ((const unsigned*)HB)[((size_t)tc_ * DM + sl * 128) / 2 + (ln_ & 7) * 8 + (ln_ >> 3)];     \
        pe0 = *(const uint4*)(EX + (size_t)tc_ * 128 + (ln_ >> 3) * 16); pe1 = *(const uint4*)(EX + (size_t)tc_ * 128 + (ln_ >> 3) * 16 + 8); }
#define U_ISSUE(BUF, HQ, SC, slot) { const unsigned ew_[8] = {pe0.x, pe0.y, pe0.z, pe0.w, pe1.x, pe1.y, pe1.z, pe1.w}; \
        _Pragma("unroll") for (int i = 0; i < 16; ++i) { BUF[i] = __builtin_amdgcn_raw_buffer_load_b128(rsU, ROW_VOFF(ew_[i >> 1], i & 1, cbase), 0, 0); } \
        { const float h0_ = __uint_as_float(ph << 16), h1_ = __uint_as_float(ph & 0xffff0000u); \
          const float am_ = wave_max_nolds(fmaxf(fabsf(h0_), fabsf(h1_))); const float inv_ = am_ > 0.f ? 127.0f * __builtin_amdgcn_rcpf(am_) : 0.f; SC = am_ * (1.0f / 127.0f); \
          const unsigned w16_ = __builtin_amdgcn_perm(__float_as_uint(fmaf(h1_, inv_, 12582912.0f)), __float_as_uint(fmaf(h0_, inv_, 12582912.0f)), 0x0c0c0400u); \
          const int ln_ = tidx() & 63; \
          hl[(slot) * 64 + (ln_ & 7) * 8 + (ln_ >> 3)] = (unsigned short)w16_; \
          const uint4 hq4_ = *(const uint4*)(hl + (slot) * 64 + (ln_ & 7) * 8); HQ[0] = hq4_.x; HQ[1] = hq4_.y; HQ[2] = hq4_.z; HQ[3] = hq4_.w; } }
#define U_COMPUTE(BUF, HQ, SC, tt) { int d[16]; \
        _Pragma("unroll") for (int i = 0; i < 16; ++i) { const u32x4v w_ = BUF[i];     \
            d[i] = __builtin_amdgcn_sdot4((int)w_.w, (int)HQ[3], __builtin_amdgcn_sdot4((int)w_.z, (int)HQ[2], __builtin_amdgcn_sdot4((int)w_.y, (int)HQ[1], __builtin_amdgcn_sdot4((int)w_.x, (int)HQ[0], 0, false), false), false), false); } \
        int r8[8], r4[4], r2v[2]; \
        _Pragma("unroll") for (int i = 0; i < 8; ++i) r8[i] = (b2 ? d[8 + i] : d[i]) + DPP_I(DPP_I(b2 ? d[i] : d[8 + i], DPP_HMIR), DPP_QREV); \
        _Pragma("unroll") for (int i = 0; i < 4; ++i) r4[i] = (b1 ? r8[4 + i] : r8[i]) + DPP_I(b1 ? r8[i] : r8[4 + i], DPP_XOR2); \
        _Pragma("unroll") for (int i = 0; i < 2; ++i) r2v[i] = (b0 ? r4[2 + i] : r4[i]) + DPP_I(b0 ? r4[i] : r4[2 + i], DPP_XOR1); \
        if ((tt) < T_TOK) ZP[((size_t)(tt) * 8 + sl) * 64 + (tidx() & 63)] = pack2((float)r2v[0] * SC, (float)r2v[1] * SC); }
#define SBAR __builtin_amdgcn_sched_barrier(0)
    for (int sl = (int)tp.jx; sl < 8; sl += (int)tp.nx) {
        const unsigned cbase = ((unsigned)sl << 21) + (unsigned)(k * 16);
        unsigned ph; uint4 pe0, pe1;
        u32x4v A[16], B[16]; unsigned hqA[4], hqB[4]; float scA, scB;
        int t = widx;
        U_LOADP(t); U_ISSUE(A, hqA, scA, 0); U_LOADP(t + nwx); SBAR;
#pragma unroll 1
        for (; t < T_TOK; t += 2 * nwx) {
            U_ISSUE(B, hqB, scB, 1); SBAR; U_LOADP(t + 2 * nwx); SBAR; U_COMPUTE(A, hqA, scA, t); SBAR;
            U_ISSUE(A, hqA, scA, 0); SBAR; U_LOADP(t + 3 * nwx); SBAR; U_COMPUTE(B, hqB, scB, t + nwx); SBAR;
        }
    }
#undef U_LOADP
#undef U_ISSUE
#undef U_COMPUTE
}
__device__ __forceinline__ void p7w_weights(const Params& p) {
    unsigned char* ws = p.ws;
    const float* GT = (const float*)(ws + OFF_GT); const unsigned* ZP = (const unsigned*)(ws + OFF_ZP); const float* SE = (const float*)(ws + OFF_SE);
    const float* rs2 = (const float*)(ws + OFF_RS2); unsigned short* QA = (unsigned short*)(ws + OFF_QA); float* SA = (float*)(ws + OFF_SA);
    const int lane = tidx() & 63;
    int t = gwave();
    if (t >= T_TOK) return;
    unsigned pz[8]; float2 pgt, pse; float pr2;
#define W_LOAD(tt) { _Pragma("unroll") for (int j = 0; j < 8; ++j) pz[j] = ZP[((size_t)(tt) * 8 + j) * 64 + lane]; \
        pgt = *(const float2*)(GT + (size_t)(tt) * 128 + 2 * lane); pse = *(const float2*)(SE + (size_t)(tt) * 128 + 2 * lane); pr2 = rs2[(tt)]; }
    W_LOAD(t);
    for (; t < T_TOK; t += nwaves()) {
        float z0 = 0.f, z1 = 0.f;
#pragma unroll
        for (int j = 0; j < 8; ++j) { z0 += __uint_as_float(pz[j] << 16); z1 += __uint_as_float(pz[j] & 0xffff0000u); }
        const float s0 = pr2 * pse.x, s1 = pr2 * pse.y, g0 = pgt.x, g1 = pgt.y;
        const int tn = t + nwaves();
        if (tn < T_TOK) W_LOAD(tn);
        const pg8::f32x2 ge = pg8::gelu_pk((pg8::f32x2){z0 * s0, z1 * s1});
        const float a0 = ge.x * g0, a1 = ge.y * g1;
        const float am = wave_max_nolds(fmaxf(fabsf(a0), fabsf(a1))); const float inv = am > 0.f ? 127.0f * __builtin_amdgcn_rcpf(am) : 0.f;
        const unsigned w16 = __builtin_amdgcn_perm(__float_as_uint(fmaf(a1, inv, 12582912.0f)), __float_as_uint(fmaf(a0, inv, 12582912.0f)), 0x0c0c0400u);
        QA[(size_t)t * 64 + lane] = (unsigned short)w16;
        if (lane == 0) SA[t] = am * (1.0f / 127.0f);
    }
#undef W_LOAD
}
#define TR4x4(B0, B1, B2, B3, T0, T1, T2, T3) { \
        const unsigned l01_ = __builtin_amdgcn_perm(B1, B0, 0x05010400u), h01_ = __builtin_amdgcn_perm(B1, B0, 0x07030602u); \
        const unsigned l23_ = __builtin_amdgcn_perm(B3, B2, 0x05010400u), h23_ = __builtin_amdgcn_perm(B3, B2, 0x07030602u); \
        T0 = __builtin_amdgcn_perm(l23_, l01_, 0x05040100u); T1 = __builtin_amdgcn_perm(l23_, l01_, 0x07060302u); \
        T2 = __builtin_amdgcn_perm(h23_, h01_, 0x05040100u); T3 = __builtin_amdgcn_perm(h23_, h01_, 0x07060302u); }
__device__ __forceinline__ void p7v_shard(const Params& p, const XTopo tp) {
    unsigned char* ws = p.ws;
    const unsigned short* EX = (const unsigned short*)(ws + OFF_EX);
    unsigned* Y = (unsigned*)(ws + OFF_Y);
    const unsigned short* QA = (const unsigned short*)(ws + OFF_QA); const float* SA = (const float*)(ws + OFF_SA);
    const __amdgpu_buffer_rsrc_t rsV = __builtin_amdgcn_make_buffer_rsrc((void*)(ws + OFF_VT8), 0, 16 << 20, 0x00020000);
    const int tid = tidx(), lane = tid & 63, wid = tid >> 6, k = lane & 7;
    const bool b5 = (lane & 32) != 0, b4 = (lane & 16) != 0, b3 = (lane & 8) != 0;
    const int nwx = (int)tp.nloc * 8, widx = (int)tp.rank * 8 + wid;
#define V_LOADP(tt) { const int tc_ = (tt) < T_TOK ? (tt) : T_TOK - 1; const int ln_ = tidx() & 63; \
        pe0 = *(const uint4*)(EX + (size_t)tc_ * 128 + (ln_ >> 3) * 16); pe1 = *(const uint4*)(EX + (size_t)tc_ * 128 + (ln_ >> 3) * 16 + 8); \
        pwq = *(const uint4*)(QA + (size_t)tc_ * 64 + (ln_ & ~7)); psa = SA[tc_]; }
#define V_ISSUE(BUF, WQ, SA_, slot) { const unsigned ew_[8] = {pe0.x, pe0.y, pe0.z, pe0.w, pe1.x, pe1.y, pe1.z, pe1.w}; \
        _Pragma("unroll") for (int i = 0; i < 16; ++i) { BUF[i] = __builtin_amdgcn_raw_buffer_load_b128(rsV, ROW_VOFF(ew_[i >> 1], i & 1, cbase), 0, 0); } \
        WQ = pwq; SA_ = psa; }
#define V_COMPUTE(BUF, WQ, SA, tt) { int y[16]; _Pragma("unroll") for (int c = 0; c < 16; ++c) y[c] = 0; \
        const unsigned wq_[4] = {WQ.x, WQ.y, WQ.z, WQ.w}; \
        _Pragma("unroll") for (int jr = 0; jr < 4; ++jr) \
            _Pragma("unroll") for (int j4 = 0; j4 < 4; ++j4) { unsigned t0_, t1_, t2_, t3_; \
                TR4x4(BUF[4 * jr][j4], BUF[4 * jr + 1][j4], BUF[4 * jr + 2][j4], BUF[4 * jr + 3][j4], t0_, t1_, t2_, t3_) \
                y[4 * j4] = __builtin_amdgcn_sdot4((int)t0_, (int)wq_[jr], y[4 * j4], false); y[4 * j4 + 1] = __builtin_amdgcn_sdot4((int)t1_, (int)wq_[jr], y[4 * j4 + 1], false); \
                y[4 * j4 + 2] = __builtin_amdgcn_sdot4((int)t2_, (int)wq_[jr], y[4 * j4 + 2], false); y[4 * j4 + 3] = __builtin_amdgcn_sdot4((int)t3_, (int)wq_[jr], y[4 * j4 + 3], false); } \
        int s8[8], s4[4], s2[2]; \
        _Pragma("unroll") for (int i = 0; i < 8; ++i) { const auto r_ = __builtin_amdgcn_permlane32_swap((unsigned)y[i], (unsigned)y[8 + i], false, false); s8[i] = (int)(r_[0] + r_[1]); } \
        _Pragma("unroll") for (int i = 0; i < 4; ++i) { const auto r_ = __builtin_amdgcn_permlane16_swap((unsigned)s8[i], (unsigned)s8[4 + i], false, false); s4[i] = (int)(r_[0] + r_[1]); } \
        _Pragma("unroll") for (int i = 0; i < 2; ++i) s2[i] = (b3 ? s4[2 + i] : s4[i]) + DPP_I(b3 ? s4[i] : s4[2 + i], DPP_ROR8); \
        if ((tt) < T_TOK) { const int ln_ = tidx() & 63; Y[((size_t)(tt) * DM + sl * 128 + (ln_ & 7) * 16 + (ln_ >> 3) * 2) >> 1] = pack2((float)s2[0] * SA, (float)s2[1] * SA); } }
    for (int sl = (int)tp.jx; sl < 8; sl += (int)tp.nx) {
        const unsigned cbase = ((unsigned)sl << 21) + (unsigned)(k * 16);
        uint4 pe0, pe1, pwq; float psa;
        u32x4v A[16], B[16]; uint4 wqA, wqB; float saA, saB;
        int t = widx;
        V_LOADP(t); V_ISSUE(A, wqA, saA, 0); V_LOADP(t + nwx); SBAR;
#pragma unroll 1
        for (; t < T_TOK; t += 2 * nwx) {
            V_ISSUE(B, wqB, saB, 1); SBAR; V_LOADP(t + 2 * nwx); SBAR; V_COMPUTE(A, wqA, saA, t); SBAR;
            V_ISSUE(A, wqA, saA, 0); SBAR; V_LOADP(t + 3 * nwx); SBAR; V_COMPUTE(B, wqB, saB, t + nwx); SBAR;
        }
    }
#undef V_LOADP
#undef V_ISSUE
#undef V_COMPUTE
#undef SBAR
}
__device__ __forceinline__ void p7f_final(const Params& p) {
    unsigned char* ws = p.ws;
    const unsigned* HB = (const unsigned*)(ws + OFF_HB); const unsigned* Y = (const unsigned*)(ws + OFF_Y);
    const int ln = tidx() & 63;
    int t0 = gwave() * 2;
    if (t0 >= T_TOK) return;
    float4 gq[4];
#pragma unroll
    for (int i = 0; i < 4; ++i) gq[i] = ((const float4*)p.gf)[ln + 64 * i];
    uint2 an[2][4], bn[2][4];
#pragma unroll
    for (int r = 0; r < 2; ++r)
#pragma unroll
        for (int i = 0; i < 4; ++i) { an[r][i] = ((const uint2*)(HB + (size_t)(t0 + r) * (DM / 2)))[ln + 64 * i]; bn[r][i] = ((const uint2*)(Y + (size_t)(t0 + r) * (DM / 2)))[ln + 64 * i]; }
    for (; t0 < T_TOK; t0 += nwaves() * 2) {
        float4 v[2][4];
#pragma unroll
        for (int r = 0; r < 2; ++r)
#pragma unroll
            for (int i = 0; i < 4; ++i) {
                const uint2 a = an[r][i], b = bn[r][i];
                v[r][i].x = __uint_as_float(a.x << 16) + __uint_as_float(b.x << 16); v[r][i].y = __uint_as_float(a.x & 0xffff0000u) + __uint_as_float(b.x & 0xffff0000u);
                v[r][i].z = __uint_as_float(a.y << 16) + __uint_as_float(b.y << 16); v[r][i].w = __uint_as_float(a.y & 0xffff0000u) + __uint_as_float(b.y & 0xffff0000u);
            }
        const int t1 = t0 + nwaves() * 2;
        if (t1 < T_TOK) {
#pragma unroll
            for (int r = 0; r < 2; ++r)
#pragma unroll
                for (int i = 0; i < 4; ++i) { an[r][i] = ((const uint2*)(HB + (size_t)(t1 + r) * (DM / 2)))[ln + 64 * i]; bn[r][i] = ((const uint2*)(Y + (size_t)(t1 + r) * (DM / 2)))[ln + 64 * i]; }
        }
#pragma unroll
        for (int r = 0; r < 2; ++r) {
            float ss = 0.f;
#pragma unroll
            for (int i = 0; i < 4; ++i) ss += v[r][i].x * v[r][i].x + v[r][i].y * v[r][i].y + v[r][i].z * v[r][i].z + v[r][i].w * v[r][i].w;
            const float rs = rsqrtf(wave_sum(ss) * (1.0f / DM) + 1e-6f);
#pragma unroll
            for (int i = 0; i < 4; ++i) {
                float4 o; o.x = v[r][i].x * rs * gq[i].x; o.y = v[r][i].y * rs * gq[i].y; o.z = v[r][i].z * rs * gq[i].z; o.w = v[r][i].w * rs * gq[i].w;
                stnt_f4(p.out + (size_t)(t0 + r) * DM + (ln + 64 * i) * 4, o);
            }
        }
    }
}

__global__ void __launch_bounds__(NTHREADS) mega_kernel(Params p) {
    extern __shared__ __attribute__((aligned(16))) unsigned char smem[];
    float* lds = (float*)smem;
    float* stg = lds + (tidx() >> 6) * STG_FLOATS;
    PG8_LAS unsigned char* ldsp = (PG8_LAS unsigned char*)smem;
    volatile LAS3 unsigned* xst = (volatile LAS3 unsigned*)((LAS3 unsigned char*)smem + pg8::STAGE_BYTES);
    if (threadIdx.x < 8) xst[threadIdx.x] = 0u;
    __syncthreads();
    const XcdBarrier xb = xcd_barrier_post((unsigned*)(p.ws + OFF_BAR), xst);
#define GSYNC() xcd_barrier(xb)
    p0_prep(p, lds); GSYNC();
    p1_g1(p, stg, ldsp); __syncthreads();
    {
        const int G = (int)gridDim.x, nkv = G >= 128 ? 64 : G;
        if ((int)blockIdx.x < nkv) p1_kv(p, ldsp, nkv);
        if (G >= 128) { if ((int)blockIdx.x >= nkv) tab_convert(p, ((int)blockIdx.x - nkv) * 8 + (tidx() >> 6), (G - nkv) * 8); }
        else tab_convert(p, gwave(), nwaves());
    }
    GSYNC();
    p2_pool(p); p2_attn(p, ldsp); __syncthreads(); p3_sgu(p, smem); GSYNC();
    p4(p, ldsp); GSYNC();
    p5(p, ldsp); GSYNC();
    p6(p, ldsp); GSYNC();
    p7a_topk(p, smem); GSYNC();
    { const XTopo tp = xcd_topology(xb, xst); p7u_shard(p, tp, smem); GSYNC(); p7w_weights(p); GSYNC(); p7v_shard(p, tp); GSYNC(); p7f_final(p); }
}

extern "C" void kernel_launch(void* const* d_in, const int* in_sizes, int n_in, void* d_out, int out_size, void* d_ws, size_t ws_size, hipStream_t stream) {
    static int grid_blocks = 0;
    if (!grid_blocks) {
        int dev = 0, cus = 0, per_cu = 0;
        (void)hipGetDevice(&dev);
        (void)hipDeviceGetAttribute(&cus, hipDeviceAttributeMultiprocessorCount, dev);
        if (hipFuncSetAttribute((const void*)mega_kernel, hipFuncAttributeMaxDynamicSharedMemorySize, LDS_BYTES) != hipSuccess) fprintf(stderr, "hipFuncSetAttribute failed\n");
        if (hipOccupancyMaxActiveBlocksPerMultiprocessor(&per_cu, mega_kernel, NTHREADS, LDS_BYTES) != hipSuccess) per_cu = 1;
        (void)hipGetLastError();
        if (per_cu > 1) per_cu = 1;
        if (per_cu < 1) per_cu = 1;
        grid_blocks = cus * per_cu;
    }
    Params p{};
    p.x = (const float*)d_in[0]; p.mem = (const float*)d_in[1]; p.g1 = (const float*)d_in[2]; p.w_in = (const float*)d_in[3];
    p.pool_w = (const float*)d_in[4]; p.pool_scale = (const float*)d_in[5]; p.ln_g = (const float*)d_in[6]; p.ln_b = (const float*)d_in[7];
    p.w_s = (const float*)d_in[8]; p.b_s = (const float*)d_in[9]; p.w_so = (const float*)d_in[10]; p.memg = (const float*)d_in[11];
    p.w_kv = (const float*)d_in[12]; p.w_xo = (const float*)d_in[13]; p.w_out = (const float*)d_in[14]; p.g2 = (const float*)d_in[15];
    p.w_q = (const float*)d_in[16]; p.k1 = (const float*)d_in[17]; p.k2 = (const float*)d_in[18]; p.pu = (const float*)d_in[19];
    p.pv = (const float*)d_in[20]; p.gf = (const float*)d_in[21];
    p.out = (float*)d_out; p.ws = (unsigned char*)d_ws;
    if (hipMemsetAsync((unsigned char*)d_ws + OFF_BAR, 0, 16384, stream) != hipSuccess) fprintf(stderr, "memset of barrier words failed\n");
    void* args[] = {&p};
    hipError_t e = hipLaunchCooperativeKernel((void*)mega_kernel, dim3(grid_blocks), dim3(NTHREADS), args, LDS_BYTES, stream);
    if (e != hipSuccess) fprintf(stderr, "cooperative launch failed: %s (grid %d)\n", hipGetErrorString(e), grid_blocks);
}
```
